# Optimizing an MI355X kernel written in HIP

```python
import math
import jax, jax.numpy as jnp
from jax import lax
import numpy as np


D_MODEL = 1024
BATCH = 16
SEQ = 2048
DEPTH = 2

D_MIX = D_MODEL
M_WIDTH = D_MIX // 2
M_HEADDIM = 64
M_HEADS = M_WIDTH // M_HEADDIM
M_GROUPS = 2
M_HPG = M_HEADS // M_GROUPS
M_STATE = 128
M_CONV = 4
M_CHUNK = 128
M_CONV_DIM = M_WIDTH + 2 * M_GROUPS * M_STATE
M_PROJ = M_WIDTH + M_CONV_DIM + M_HEADS
S_WIDTH = D_MIX // 4
S_GROUP_CH = 16
S_GROUPS = S_WIDTH // S_GROUP_CH
S_STATE = 64
R_WIDTH = D_MIX - M_WIDTH - S_WIDTH
R_HEADDIM = 64
R_HEADS = R_WIDTH // R_HEADDIM
R_DECAY_LORA = 32
R_AAA_LORA = 32
R_GATE_LORA = 64
R_PROJ = 3 * R_WIDTH + R_DECAY_LORA + R_AAA_LORA + R_GATE_LORA
D_IN = M_PROJ + S_WIDTH + R_PROJ
D_FF = 2816
NORM_EPS = 1e-5
RWKV_GN_EPS = 64e-5
MACARON_WEIGHT = 0.5

kernel_name = 'hybrid_ssd_s5_rwkv7_macaron'


def rmsnorm(x, g, eps=NORM_EPS):
    xf = x.astype(jnp.float32)
    y = xf * lax.rsqrt(jnp.mean(xf * xf, axis=-1, keepdims=True) + eps)
    return y * g.astype(jnp.float32)


def swiglu(h, wg, wu, wd):
    return (jax.nn.silu(h @ wg) * (h @ wu)) @ wd


def token_shift(u):
    return jnp.pad(u[:, :-1], ((0, 0), (1, 0), (0, 0)))


def causal_dwconv(u, w, b):
    L = u.shape[1]
    up = jnp.pad(u, ((0, 0), (M_CONV - 1, 0), (0, 0)))
    out = b
    for j in range(M_CONV):
        out = out + up[:, j:j + L] * w[:, j]
    return out


def segsum(x):
    T = x.shape[-1]
    xr = jnp.broadcast_to(x[..., None], x.shape + (T,))
    xr = jnp.where(jnp.tril(jnp.ones((T, T), dtype=bool), -1), xr, 0.0)
    xs = jnp.cumsum(xr, axis=-2)
    return jnp.where(jnp.tril(jnp.ones((T, T), dtype=bool), 0), xs, -jnp.inf)


def ssd_mixer(u, A_log, dt_bias, conv_w, conv_b, D_skip, norm_w):
    bsz, L, _ = u.shape
    nc = L // M_CHUNK
    z, xbc, dt_raw = jnp.split(u, [M_WIDTH, M_WIDTH + M_CONV_DIM], axis=-1)
    xbc = jax.nn.silu(causal_dwconv(xbc, conv_w, conv_b))
    xs, Bm, Cm = jnp.split(xbc, [M_WIDTH, M_WIDTH + M_GROUPS * M_STATE], axis=-1)
    dt = jax.nn.softplus(dt_raw + dt_bias)
    A = -jnp.exp(A_log.astype(jnp.float32))
    xs = xs.reshape(bsz, nc, M_CHUNK, M_GROUPS, M_HPG, M_HEADDIM)
    Bm = Bm.reshape(bsz, nc, M_CHUNK, M_GROUPS, M_STATE)
    Cm = Cm.reshape(bsz, nc, M_CHUNK, M_GROUPS, M_STATE)
    dt = dt.reshape(bsz, nc, M_CHUNK, M_GROUPS, M_HPG)
    X = xs * dt[..., None]
    dA = jnp.transpose(dt * A.reshape(M_GROUPS, M_HPG), (0, 3, 4, 1, 2))
    A_cs = jnp.cumsum(dA, axis=-1)
    Lmat = jnp.exp(segsum(dA))
    CB = jnp.einsum('bclgn,bcsgn->bgcls', Cm, Bm)
    y_diag = jnp.einsum('bgrcls,bcsgrp->bclgrp', CB[:, :, None] * Lmat, X)
    decay_states = jnp.exp(A_cs[..., -1:] - A_cs)
    states = jnp.einsum('bclgn,bgrcl,bclgrp->bcgrpn', Bm, decay_states, X)
    A_last = jnp.pad(A_cs[..., -1], ((0, 0), (0, 0), (0, 0), (1, 0)))
    decay_chunk = jnp.exp(segsum(A_last))
    states = jnp.concatenate([jnp.zeros_like(states[:, :1]), states], axis=1)
    states = jnp.einsum('bgrzc,bcgrpn->bzgrpn', decay_chunk, states)[:, :-1]
    y_off = jnp.einsum('bclgn,bcgrpn,bgrcl->bclgrp', Cm, states, jnp.exp(A_cs))
    y = y_diag + y_off + xs * D_skip.reshape(M_GROUPS, M_HPG)[:, :, None]
    y = y.reshape(bsz, L, M_WIDTH)
    return rmsnorm(y * jax.nn.silu(z), norm_w)


def s5_mixer(u, A_re, A_im, B_re, B_im, C_re, C_im, log_dt, D_skip, glu_w, glu_b):
    bsz, L, _ = u.shape
    f32 = jnp.float32
    A_re, A_im = A_re.astype(f32), A_im.astype(f32)
    B_re, B_im = B_re.astype(f32), B_im.astype(f32)
    dt = jnp.exp(log_dt.astype(f32))[:, None]
    mag = jnp.exp(A_re * dt)
    abar_re, abar_im = mag * jnp.cos(A_im * dt), mag * jnp.sin(A_im * dt)
    den = A_re * A_re + A_im * A_im
    nr, ni = abar_re - 1.0, abar_im
    coef_re = (nr * A_re + ni * A_im) / den
    coef_im = (ni * A_re - nr * A_im) / den
    Bb_re = coef_re[..., None] * B_re - coef_im[..., None] * B_im
    Bb_im = coef_re[..., None] * B_im + coef_im[..., None] * B_re
    ug = u.reshape(bsz, L, S_GROUPS, S_GROUP_CH)
    bu_re = jnp.einsum('blgh,gph->blgp', ug, Bb_re)
    bu_im = jnp.einsum('blgh,gph->blgp', ug, Bb_im)
    a_re = jnp.broadcast_to(abar_re, bu_re.shape)
    a_im = jnp.broadcast_to(abar_im, bu_im.shape)

    def combine(e1, e2):
        a1r, a1i, b1r, b1i = e1
        a2r, a2i, b2r, b2i = e2
        return (a2r * a1r - a2i * a1i, a2r * a1i + a2i * a1r,
                a2r * b1r - a2i * b1i + b2r, a2r * b1i + a2i * b1r + b2i)

    _, _, xr, xi = lax.associative_scan(combine, (a_re, a_im, bu_re, bu_im), axis=1)
    y = (jnp.einsum('ghp,blgp->blgh', C_re, xr)
         - jnp.einsum('ghp,blgp->blgh', C_im, xi))
    y = y.reshape(bsz, L, S_WIDTH) + D_skip * u
    y = jax.nn.gelu(y)
    return y * jax.nn.sigmoid(y @ glu_w + glu_b)


def rwkv7_mixer(u, mu, w0, w2, a0, a2, g2, k_k, k_a, r_k, gn_w, gn_b):
    bsz, L, _ = u.shape
    u = u + (token_shift(u) - u) * mu
    r, k, v, wl, al, gl = jnp.split(
        u, [R_WIDTH, 2 * R_WIDTH, 3 * R_WIDTH, 3 * R_WIDTH + R_DECAY_LORA,
            3 * R_WIDTH + R_DECAY_LORA + R_AAA_LORA], axis=-1)
    w_log = -jax.nn.softplus(-(w0 + jnp.tanh(wl) @ w2)) - 0.5
    decay = jnp.exp(-jnp.exp(w_log))
    a = jax.nn.sigmoid(a0 + al @ a2)
    g = jax.nn.sigmoid(gl) @ g2
    heads = lambda t: t.reshape(bsz, L, R_HEADS, R_HEADDIM)
    kk = heads(k * k_k)
    kk = kk / jnp.maximum(jnp.sqrt(jnp.sum(kk * kk, axis=-1, keepdims=True)), 1e-12)
    k = k * (1.0 + (a - 1.0) * k_a)
    r_h, k_h, v_h, w_h, a_h = heads(r), heads(k), heads(v), heads(decay), heads(a)

    def step(S, inp):
        rt, wt, kt, vt, kkt, at = inp
        sa = jnp.einsum('bhvk,bhk->bhv', S, -kkt)
        S = (S * wt[:, :, None, :] + sa[..., None] * (kkt * at)[:, :, None, :]
             + vt[..., None] * kt[:, :, None, :])
        return S, jnp.einsum('bhvk,bhk->bhv', S, rt)

    S0 = jnp.zeros((bsz, R_HEADS, R_HEADDIM, R_HEADDIM), jnp.float32)
    xs = tuple(jnp.moveaxis(t, 1, 0) for t in (r_h, w_h, k_h, v_h, kk, a_h))
    _, y = lax.scan(step, S0, xs)
    y = jnp.moveaxis(y, 0, 1)
    mean = jnp.mean(y, axis=-1, keepdims=True)
    var = jnp.mean(jnp.square(y - mean), axis=-1, keepdims=True)
    y = ((y - mean) * lax.rsqrt(var + RWKV_GN_EPS)).reshape(bsz, L, R_WIDTH) * gn_w + gn_b
    bonus = jnp.sum(r_h * k_h * r_k, axis=-1, keepdims=True) * v_h
    y = y + bonus.reshape(bsz, L, R_WIDTH)
    return y * g


def setup_inputs(seed: int = 0) -> dict:
    key = jax.random.key(seed)
    ks = iter(jax.random.split(key, 64))
    f32 = jnp.float32
    nrm = lambda shape, s: s * jax.random.normal(next(ks), shape, f32)
    gain = lambda shape: 1.0 + 0.02 * jax.random.normal(next(ks), shape, f32)
    unif = lambda shape, lo, hi: jax.random.uniform(next(ks), shape, f32, lo, hi)
    Dn = DEPTH
    inp = {}
    inp['x'] = nrm((BATCH, SEQ, D_MODEL), 1.0)
    inp['ffn1_norm'] = gain((Dn, D_MODEL))
    inp['ffn1_wg'] = nrm((Dn, D_MODEL, D_FF), D_MODEL ** -0.5)
    inp['ffn1_wu'] = nrm((Dn, D_MODEL, D_FF), D_MODEL ** -0.5)
    inp['ffn1_wd'] = nrm((Dn, D_FF, D_MODEL), D_FF ** -0.5)
    inp['mix_norm'] = gain((Dn, D_MODEL))
    inp['w_in'] = nrm((Dn, D_MODEL, D_IN), D_MODEL ** -0.5)
    inp['w_out'] = nrm((Dn, D_MIX, D_MODEL), D_MIX ** -0.5)
    inp['m_A_log'] = jnp.log(unif((Dn, M_HEADS), 1.0, 16.0))
    dt0 = jnp.exp(unif((Dn, M_HEADS), math.log(1e-3), math.log(1e-1)))
    inp['m_dt_bias'] = dt0 + jnp.log(-jnp.expm1(-dt0))
    inp['m_conv_w'] = nrm((Dn, M_CONV_DIM, M_CONV), M_CONV ** -0.5)
    inp['m_conv_b'] = nrm((Dn, M_CONV_DIM), 0.02)
    inp['m_D'] = gain((Dn, M_HEADS))
    inp['m_norm_w'] = gain((Dn, M_WIDTH))
    inp['s_A_re'] = -0.5 + nrm((Dn, S_GROUPS, S_STATE), 0.01)
    inp['s_A_im'] = math.pi * jnp.arange(S_STATE, dtype=f32) + nrm((Dn, S_GROUPS, S_STATE), 0.01)
    inp['s_B_re'] = nrm((Dn, S_GROUPS, S_STATE, S_GROUP_CH), (2 * S_GROUP_CH) ** -0.5)
    inp['s_B_im'] = nrm((Dn, S_GROUPS, S_STATE, S_GROUP_CH), (2 * S_GROUP_CH) ** -0.5)
    inp['s_C_re'] = nrm((Dn, S_GROUPS, S_GROUP_CH, S_STATE), S_STATE ** -0.5)
    inp['s_C_im'] = nrm((Dn, S_GROUPS, S_GROUP_CH, S_STATE), S_STATE ** -0.5)
    inp['s_log_dt'] = unif((Dn, S_GROUPS), math.log(1e-3), math.log(1e-1))
    inp['s_D'] = nrm((Dn, S_WIDTH), 1.0)
    inp['s_glu_w'] = nrm((Dn, S_WIDTH, S_WIDTH), S_WIDTH ** -0.5)
    inp['s_glu_b'] = nrm((Dn, S_WIDTH), 0.02)
    inp['r_mu'] = unif((Dn, R_PROJ), 0.0, 1.0)
    inp['r_w0'] = unif((Dn, R_WIDTH), -6.0, 1.0)
    inp['r_w2'] = nrm((Dn, R_DECAY_LORA, R_WIDTH), 0.1 * R_DECAY_LORA ** -0.5)
    inp['r_a0'] = nrm((Dn, R_WIDTH), 0.1)
    inp['r_a2'] = nrm((Dn, R_AAA_LORA, R_WIDTH), 0.1 * R_AAA_LORA ** -0.5)
    inp['r_g2'] = nrm((Dn, R_GATE_LORA, R_WIDTH), R_GATE_LORA ** -0.5)
    inp['r_k_k'] = 0.85 + nrm((Dn, R_WIDTH), 0.02)
    inp['r_k_a'] = gain((Dn, R_WIDTH))
    inp['r_r_k'] = nrm((Dn, R_HEADS, R_HEADDIM), 0.1)
    inp['r_gn_w'] = gain((Dn, R_WIDTH))
    inp['r_gn_b'] = nrm((Dn, R_WIDTH), 0.02)
    inp['ffn2_norm'] = gain((Dn, D_MODEL))
    inp['ffn2_wg'] = nrm((Dn, D_MODEL, D_FF), D_MODEL ** -0.5)
    inp['ffn2_wu'] = nrm((Dn, D_MODEL, D_FF), D_MODEL ** -0.5)
    inp['ffn2_wd'] = nrm((Dn, D_FF, D_MODEL), D_FF ** -0.5)
    inp['final_norm'] = gain((D_MODEL,))
    return inp


def reference(x, ffn1_norm, ffn1_wg, ffn1_wu, ffn1_wd, mix_norm, w_in, w_out,
              m_A_log, m_dt_bias, m_conv_w, m_conv_b, m_D, m_norm_w,
              s_A_re, s_A_im, s_B_re, s_B_im, s_C_re, s_C_im, s_log_dt, s_D, s_glu_w, s_glu_b,
              r_mu, r_w0, r_w2, r_a0, r_a2, r_g2, r_k_k, r_k_a, r_r_k, r_gn_w, r_gn_b,
              ffn2_norm, ffn2_wg, ffn2_wu, ffn2_wd, final_norm):
    for i in range(DEPTH):
        h = rmsnorm(x, ffn1_norm[i])
        x = x + (MACARON_WEIGHT * swiglu(h, ffn1_wg[i], ffn1_wu[i], ffn1_wd[i])).astype(x.dtype)
        h = rmsnorm(x, mix_norm[i])
        u = h @ w_in[i]
        u_m, u_s, u_r = jnp.split(u, [M_PROJ, M_PROJ + S_WIDTH], axis=-1)
        y_m = ssd_mixer(u_m, m_A_log[i], m_dt_bias[i], m_conv_w[i], m_conv_b[i], m_D[i], m_norm_w[i])
        y_s = s5_mixer(u_s, s_A_re[i], s_A_im[i], s_B_re[i], s_B_im[i], s_C_re[i], s_C_im[i],
                       s_log_dt[i], s_D[i], s_glu_w[i], s_glu_b[i])
        y_r = rwkv7_mixer(u_r, r_mu[i], r_w0[i], r_w2[i], r_a0[i], r_a2[i], r_g2[i],
                          r_k_k[i], r_k_a[i], r_r_k[i], r_gn_w[i], r_gn_b[i])
        y = jnp.concatenate([y_m, y_s, y_r], axis=-1)
        x = x + (y @ w_out[i]).astype(x.dtype)
        h = rmsnorm(x, ffn2_norm[i])
        x = x + (MACARON_WEIGHT * swiglu(h, ffn2_wg[i], ffn2_wu[i], ffn2_wd[i])).astype(x.dtype)
    return rmsnorm(x, final_norm).astype(x.dtype)
```

```cpp
#include <hip/hip_runtime.h>
#include <hip/hip_cooperative_groups.h>
#include <cstdio>
#include <cstdint>
namespace cg = cooperative_groups;

#define LAS __attribute__((address_space(3)))
typedef unsigned short bf16_t;
typedef short bf16x8 __attribute__((ext_vector_type(8)));
typedef float f32x4 __attribute__((ext_vector_type(4)));
typedef float f32x2 __attribute__((ext_vector_type(2)));
typedef unsigned u32x4 __attribute__((ext_vector_type(4)));
typedef unsigned u32x2 __attribute__((ext_vector_type(2)));

__device__ __forceinline__ unsigned cvt_pk_bf16(float lo, float hi) { unsigned r; asm("v_cvt_pk_bf16_f32 %0, %1, %2" : "=v"(r) : "v"(lo), "v"(hi)); return r; }
__device__ __forceinline__ bf16_t f2bf(float f) { return (bf16_t)(cvt_pk_bf16(f, 0.f) & 0xffffu); }
__device__ __forceinline__ float bf2f(unsigned b) { return __uint_as_float(b << 16); }
__device__ __forceinline__ float bflo(unsigned w) { return __uint_as_float(w << 16); }
__device__ __forceinline__ float bfhi(unsigned w) { return __uint_as_float(w & 0xffff0000u); }
typedef _Float16 f16x8 __attribute__((ext_vector_type(8)));
typedef _Float16 f16x2 __attribute__((ext_vector_type(2)));
__device__ __forceinline__ unsigned cvt_pk_f16(float lo, float hi) { union { f16x2 h; unsigned u; } c; c.h[0] = (_Float16)lo; c.h[1] = (_Float16)hi; return c.u; }
__device__ __forceinline__ float f16lo(unsigned w) { union { f16x2 h; unsigned u; } c; c.u = w; return (float)c.h[0]; }
__device__ __forceinline__ float f16hi(unsigned w) { union { f16x2 h; unsigned u; } c; c.u = w; return (float)c.h[1]; }
__device__ __forceinline__ float sigmoidf_(float x) { return __builtin_amdgcn_rcpf(1.0f + __expf(-x)); }
__device__ __forceinline__ float siluf_(float x) { return x * sigmoidf_(x); }
__device__ __forceinline__ float tanhf_(float x) { return 1.0f - 2.0f * __builtin_amdgcn_rcpf(1.0f + __expf(2.0f * x)); }
__device__ __forceinline__ float softplusf_(float x) { return x > 20.f ? x : __logf(1.0f + __expf(x)); }
__device__ __forceinline__ float wave_sum64(float v) {
    v += __shfl_xor(v, 32); v += __shfl_xor(v, 16); v += __shfl_xor(v, 8); v += __shfl_xor(v, 4); v += __shfl_xor(v, 2); v += __shfl_xor(v, 1); return v;
}
__device__ __forceinline__ float dpp_row_sum16(float v) {
    int x;
    x = __builtin_amdgcn_update_dpp(0, __float_as_int(v), 0xB1, 0xF, 0xF, true); v += __int_as_float(x);
    x = __builtin_amdgcn_update_dpp(0, __float_as_int(v), 0x4E, 0xF, 0xF, true); v += __int_as_float(x);
    x = __builtin_amdgcn_update_dpp(0, __float_as_int(v), 0x141, 0xF, 0xF, true); v += __int_as_float(x);
    x = __builtin_amdgcn_update_dpp(0, __float_as_int(v), 0x140, 0xF, 0xF, true); v += __int_as_float(x);
    return v;
}

__device__ __forceinline__ float wave_sum64_dpp(float v) {
    v = dpp_row_sum16(v);
    const int iv = __float_as_int(v);
    return (__int_as_float(__builtin_amdgcn_readlane(iv, 0)) + __int_as_float(__builtin_amdgcn_readlane(iv, 16))) + (__int_as_float(__builtin_amdgcn_readlane(iv, 32)) + __int_as_float(__builtin_amdgcn_readlane(iv, 48)));
}
constexpr int T = 32768, SEQ = 2048, D = 1024, FF = 2816, DINP = 2816;
constexpr int Z0 = 0, XBC0 = 512, DT0 = 1536, US0 = 1544, UR0 = 1800;
constexpr float EPS = 1e-5f;
enum { I_X = 0, I_F1N, I_F1G, I_F1U, I_F1D, I_MN, I_WIN, I_WOUT, I_MALOG, I_MDTB, I_MCW, I_MCB, I_MD, I_MNW,
       I_SARE, I_SAIM, I_SBRE, I_SBIM, I_SCRE, I_SCIM, I_SLDT, I_SD, I_SGW, I_SGB,
       I_RMU, I_RW0, I_RW2, I_RA0, I_RA2, I_RG2, I_RKK, I_RKA, I_RRK, I_RGNW, I_RGNB,
       I_F2N, I_F2G, I_F2U, I_F2D, I_FN, N_IN };

constexpr size_t WB_GU = (size_t)5632 * 1024, WB_D = (size_t)1024 * 2816, WB_IN = (size_t)2816 * 1024, WB_OUT = (size_t)1024 * 1024, WB_GLU = 256 * 256;
constexpr size_t LW_GU1 = 0, LW_D1 = LW_GU1 + WB_GU, LW_IN = LW_D1 + WB_D, LW_OUT = LW_IN + WB_IN, LW_GU2 = LW_OUT + WB_OUT, LW_D2 = LW_GU2 + WB_GU, LW_GLU = LW_D2 + WB_D, LW = LW_GLU + WB_GLU;
constexpr size_t WS_W = 0;
constexpr size_t WS_XB = WS_W + 2 * LW * 2;
constexpr size_t WS_Y = WS_XB + (size_t)T * 1024 * 2;
constexpr size_t WS_ACT = WS_Y + (size_t)T * 1024 * 2;
constexpr size_t WS_DT = WS_ACT + (size_t)T * 2816 * 2;
constexpr size_t WS_SSQ = WS_DT + (size_t)T * 8 * 4;
constexpr size_t WS_YM = WS_SSQ + (size_t)T * 16 * 4;
constexpr size_t WS_YS = WS_YM + (size_t)T * 512 * 2;
constexpr size_t WS_YR = WS_YS + (size_t)T * 256 * 2;
constexpr size_t WS_SL = WS_YR + (size_t)T * 256 * 2;
constexpr size_t WS_DEC = WS_SL + (size_t)16 * 8 * 8 * 8192 * 2;
constexpr size_t WS_BAR = WS_DEC + 16 * 8 * 8 * 4;
constexpr size_t WS_BCC = WS_BAR + 4096 * 4;
constexpr size_t WS_END = WS_BCC + (size_t)T * 512 * 2;
static_assert(WS_END <= (size_t)536870912, "workspace");
constexpr int LDS_BYTES = 152 * 1024;

struct Params { const float* in[N_IN]; float* out; unsigned char* ws; int ph_lo, ph_hi; };
typedef const __attribute__((address_space(4))) Params* KP;
__device__ __forceinline__ KP fresh_kp() { KP k = (KP)__builtin_amdgcn_kernarg_segment_ptr(); asm volatile("" : "+s"(k)); return k; }

namespace pg8 {
constexpr int BM = 256, BK = 64, HALF = 128, HTB = HALF * BK * 2, STAGE_BYTES = 8 * HTB, NXCD = 8, WGM = 8;
__host__ __device__ __forceinline__ int lds_byte(int r, int c) { const int st = (r >> 4) * 2 + (c >> 5), rr = r & 15, cc = c & 31, ob = rr * 64 + cc * 2; return st * 1024 + (ob ^ (((ob >> 9) & 1) << 5)); }
__host__ __device__ __forceinline__ void stage_rc(int b, int& R, int& C) { const int st = b / 1024, sb = b % 1024, swz = sb ^ (((sb >> 9) & 1) << 5); R = (st >> 1) * 16 + swz / 64; C = (st & 1) * 32 + (swz % 64) / 2; }
__host__ __device__ __forceinline__ int perm32(int rho) { const int n = rho >> 4, i = rho & 15; return 8 * (i >> 2) + 4 * n + (i & 3); }
struct Unit { int pm, pn; };
struct Gemm { const bf16_t* A; const bf16_t* Bt; int M, N, K; };
struct StaticOrder {
    int nM, nN, nwg, G, c;
    __host__ __device__ void init(int M, int N, int G_, int c_) { nM = M / BM; nN = N / BM; nwg = nM * nN; G = G_; c = c_; }
    __host__ __device__ bool next(int i, Unit& u) const {
        const long L = (long)i * G + c; if (L >= nwg) return false;
        int wgid = (int)L; { const int q = nwg / NXCD, r = nwg % NXCD, xcd = wgid % NXCD, off = wgid / NXCD; wgid = (xcd < r ? xcd * (q + 1) : r * (q + 1) + (xcd - r) * q) + off; }
        const int nig = WGM * nN, gid = wgid / nig, fm = gid * WGM, gsz = (nM - fm) < WGM ? (nM - fm) : WGM;
        u.pm = fm + ((wgid % nig) % gsz); u.pn = (wgid % nig) / gsz; return true;
    }
};
template <bool F16 = false, class Epi>
__device__ __forceinline__ void gemm_phase(LAS unsigned char* lds, const Gemm g, const StaticOrder& S, const Epi& E) {
    const int tid = threadIdx.x, wid = __builtin_amdgcn_readfirstlane(tid >> 6), lane = tid & 63, wr = wid >> 2, wc = wid & 3, fr = lane & 15, fq = lane >> 4;
    const int K = g.K, nt = K / BK;
    unsigned voffA[2], voffB[2];
#pragma unroll
    for (int i = 0; i < 2; ++i) { int R, C; stage_rc(tid * 16 + i * 8192, R, C); const int Rb = Epi::PERM ? ((R & ~31) + perm32(R & 31)) : R;
        voffA[i] = (unsigned)(R * K + C) * 2u; voffB[i] = (unsigned)(Rb * K + C) * 2u; }
    const size_t kstep = (size_t)(BK * 2);
    const size_t hstep = (size_t)HALF * K * 2;
    const size_t tstep = 2 * hstep;
    const unsigned ldsw = (unsigned)wid * 1024u;
    const int aoff = lds_byte(wr * 64 + fr, fq * 8), boff = lds_byte(wc * 32 + fr, fq * 8);
#define PG8_SA(b, h) (((b) * 2 + (h)) * HTB)
#define PG8_SB(b, h) ((4 + (b) * 2 + (h)) * HTB)
#define PG8_STAGE(bufoff, gbase, voff) do { _Pragma("unroll") for (int _i = 0; _i < 2; ++_i) \
        __builtin_amdgcn_global_load_lds((const unsigned*)((const char*)(gbase) + (voff)[_i]), (LAS unsigned*)(lds + (bufoff) + ldsw + _i * 8192), 16, 0, 0); } while (0)
#define PG8_LDA(dst, b, h) do { _Pragma("unroll") for (int m = 0; m < 4; ++m) _Pragma("unroll") for (int k = 0; k < 2; ++k) dst[m][k] = *(const LAS bf16x8*)(lds + PG8_SA(b, h) + aoff + m * 2048 + k * 1024); } while (0)
#define PG8_LDB(dst, b, h) do { _Pragma("unroll") for (int n = 0; n < 2; ++n) _Pragma("unroll") for (int k = 0; k < 2; ++k) dst[n][k] = *(const LAS bf16x8*)(lds + PG8_SB(b, h) + boff + n * 2048 + k * 1024); } while (0)
#define PG8_MMA(ai, bj, At, Bt) do { __builtin_amdgcn_s_setprio(1); _Pragma("unroll") for (int m = 0; m < 4; ++m) _Pragma("unroll") for (int n = 0; n < 2; ++n) _Pragma("unroll") for (int k = 0; k < 2; ++k) \
        acc[ai][bj][m][n] = F16 ? __builtin_amdgcn_mfma_f32_16x16x32_f16(__builtin_bit_cast(f16x8, Bt[n][k]), __builtin_bit_cast(f16x8, At[m][k]), acc[ai][bj][m][n], 0, 0, 0) \
                                : __builtin_amdgcn_mfma_f32_16x16x32_bf16(Bt[n][k], At[m][k], acc[ai][bj][m][n], 0, 0, 0); __builtin_amdgcn_s_setprio(0); } while (0)
#define PG8_WAIT_V(n) asm volatile("s_waitcnt vmcnt(" #n ")" ::: "memory")
#define PG8_WAIT_L(n) asm volatile("s_waitcnt lgkmcnt(" #n ")" ::: "memory")
#define PG8_BAR __builtin_amdgcn_s_barrier()
#define PG8_SCHED __builtin_amdgcn_sched_barrier(0)
    Unit cur, nxt; int ui = 0;
    if (!S.next(0, cur)) return;
    f32x4 acc[2][2][4][2];
#pragma unroll
    for (int a = 0; a < 2; ++a)
#pragma unroll
        for (int b = 0; b < 2; ++b)
#pragma unroll
            for (int m = 0; m < 4; ++m)
#pragma unroll
                for (int n = 0; n < 2; ++n) acc[a][b][m][n] = (f32x4){0.f, 0.f, 0.f, 0.f};
    bf16x8 At[4][2], B0[2][2], B1[2][2];
    const char* cA = (const char*)g.A + (size_t)cur.pm * tstep; const char* cB = (const char*)g.Bt + (size_t)cur.pn * tstep;
    PG8_STAGE(PG8_SB(0, 0), cB, voffB); PG8_STAGE(PG8_SB(0, 1), cB + hstep, voffB); PG8_STAGE(PG8_SA(0, 0), cA, voffA); PG8_STAGE(PG8_SA(0, 1), cA + hstep, voffA);
    if (wr == 1) PG8_BAR;
    PG8_WAIT_V(2); PG8_BAR;
    PG8_STAGE(PG8_SB(1, 0), cB + kstep, voffB); PG8_STAGE(PG8_SA(1, 0), cA + kstep, voffA); PG8_STAGE(PG8_SB(1, 1), cB + hstep + kstep, voffB);
    PG8_WAIT_V(6); PG8_BAR;
    for (;;) {
        const bool has_next = S.next(ui + 1, nxt);
        const char* nA = has_next ? (const char*)g.A + (size_t)nxt.pm * tstep : cA; const char* nB = has_next ? (const char*)g.Bt + (size_t)nxt.pn * tstep : cB;
        for (int t = 0; t < nt; t += 2) {
            const bool last = (t == nt - 2);
            const char* a1 = cA + (size_t)(t + 1) * kstep;
            const char* a2 = last ? nA : cA + (size_t)(t + 2) * kstep; const char* b2 = last ? nB : cB + (size_t)(t + 2) * kstep;
            const char* a3 = a2 + kstep; const char* b3 = b2 + kstep;
            PG8_LDB(B0, 0, 0); PG8_LDB(B1, 0, 1); PG8_SCHED; PG8_LDA(At, 0, 0); PG8_STAGE(PG8_SA(1, 1), a1 + hstep, voffA);
            PG8_WAIT_V(8); PG8_WAIT_L(0); PG8_BAR; PG8_MMA(0, 0, At, B0); PG8_MMA(0, 1, At, B1); PG8_BAR; PG8_SCHED;
            PG8_LDA(At, 0, 1); PG8_STAGE(PG8_SB(0, 0), b2, voffB); PG8_STAGE(PG8_SB(0, 1), b2 + hstep, voffB); PG8_STAGE(PG8_SA(0, 0), a2, voffA);
            PG8_WAIT_V(8); PG8_WAIT_L(0); PG8_BAR; PG8_MMA(1, 0, At, B0); PG8_MMA(1, 1, At, B1); PG8_BAR; PG8_SCHED;
            PG8_LDB(B0, 1, 0); PG8_LDB(B1, 1, 1); PG8_SCHED; PG8_LDA(At, 1, 0); PG8_STAGE(PG8_SA(0, 1), a2 + hstep, voffA);
            PG8_WAIT_V(8); PG8_WAIT_L(0); PG8_BAR; PG8_MMA(0, 0, At, B0); PG8_MMA(0, 1, At, B1); PG8_BAR; PG8_SCHED;
            PG8_LDA(At, 1, 1); PG8_STAGE(PG8_SB(1, 0), b3, voffB); PG8_STAGE(PG8_SB(1, 1), b3 + hstep, voffB); PG8_STAGE(PG8_SA(1, 0), a3, voffA);
            PG8_WAIT_V(8); PG8_WAIT_L(0); PG8_BAR; PG8_MMA(1, 0, At, B0); PG8_MMA(1, 1, At, B1); PG8_BAR; PG8_SCHED;
        }
        if (wr == 0) PG8_BAR;
        E(acc, cur, wr, wc, fr, fq);
        if (!has_next) break;
#pragma unroll
        for (int a = 0; a < 2; ++a)
#pragma unroll
            for (int b = 0; b < 2; ++b)
#pragma unroll
                for (int m = 0; m < 4; ++m)
#pragma unroll
                    for (int n = 0; n < 2; ++n) acc[a][b][m][n] = (f32x4){0.f, 0.f, 0.f, 0.f};
        cur = nxt; cA = nA; cB = nB; ++ui;
        if (wr == 1) PG8_BAR;
    }
    PG8_WAIT_V(0);
    PG8_BAR;
#undef PG8_SA
#undef PG8_SB
#undef PG8_STAGE
#undef PG8_LDA
#undef PG8_LDB
#undef PG8_MMA
#undef PG8_WAIT_V
#undef PG8_WAIT_L
#undef PG8_BAR
#undef PG8_SCHED
}
}

__device__ __forceinline__ float row_rstd(const float* ssq, int r) { return rsqrtf(ssq[r] * (1.0f / 1024.0f) + EPS); }
struct EpiSwiglu {
    static constexpr bool PERM = true;
    bf16_t* O; const float* ssq;
    __device__ __forceinline__ void operator()(const f32x4 (&acc)[2][2][4][2], const pg8::Unit& u, int wr, int wc, int fr, int fq) const {
        const int row0 = u.pm * 256 + wr * 64 + fr, col0 = u.pn * 128 + wc * 32 + 8 * fq;
        float sq[2][4];
#pragma unroll
        for (int ai = 0; ai < 2; ++ai)
#pragma unroll
            for (int m = 0; m < 4; ++m) sq[ai][m] = ssq[row0 + ai * 128 + m * 16];
#pragma unroll
        for (int ai = 0; ai < 2; ++ai)
#pragma unroll
            for (int m = 0; m < 4; ++m) {
                const int r = row0 + ai * 128 + m * 16; const float rs = rsqrtf(sq[ai][m] * (1.0f / 1024.0f) + EPS);
                float o[8];
#pragma unroll
                for (int n = 0; n < 2; ++n)
#pragma unroll
                    for (int j = 0; j < 4; ++j) { const float gv = acc[ai][0][m][n][j] * rs, uv = acc[ai][1][m][n][j] * rs; o[n * 4 + j] = siluf_(gv) * uv; }
                u32x4 w; w.x = cvt_pk_bf16(o[0], o[1]); w.y = cvt_pk_bf16(o[2], o[3]); w.z = cvt_pk_bf16(o[4], o[5]); w.w = cvt_pk_bf16(o[6], o[7]);
                *(u32x4*)(O + (size_t)r * FF + col0) = w;
            }
    }
};
struct EpiResid {
    static constexpr bool PERM = true;
    bf16_t* xb; float* ssq; float scale;
    __device__ __forceinline__ void operator()(const f32x4 (&acc)[2][2][4][2], const pg8::Unit& u, int wr, int wc, int fr, int fq) const {
        const int row0 = u.pm * 256 + wr * 64 + fr, col0 = u.pn * 256 + wc * 32 + 8 * fq;
#pragma unroll
        for (int ai = 0; ai < 2; ++ai)
#pragma unroll
            for (int m = 0; m < 4; ++m) {
                const int r = row0 + ai * 128 + m * 16; float s = 0.f;
#pragma unroll
                for (int bj = 0; bj < 2; ++bj) {
                    bf16_t* px = xb + (size_t)r * D + col0 + bj * 128;
                    const u32x4 xo = *(const u32x4*)px;
                    const f32x4 a0 = acc[ai][bj][m][0] * scale, a1 = acc[ai][bj][m][1] * scale;
                    float v[8];
                    v[0] = f16lo(xo.x) + a0[0]; v[1] = f16hi(xo.x) + a0[1]; v[2] = f16lo(xo.y) + a0[2]; v[3] = f16hi(xo.y) + a0[3];
                    v[4] = f16lo(xo.z) + a1[0]; v[5] = f16hi(xo.z) + a1[1]; v[6] = f16lo(xo.w) + a1[2]; v[7] = f16hi(xo.w) + a1[3];
                    u32x4 w; w.x = cvt_pk_f16(v[0], v[1]); w.y = cvt_pk_f16(v[2], v[3]); w.z = cvt_pk_f16(v[4], v[5]); w.w = cvt_pk_f16(v[6], v[7]);
                    *(u32x4*)px = w;
                    s += ((v[0] * v[0] + v[1] * v[1]) + (v[2] * v[2] + v[3] * v[3])) + ((v[4] * v[4] + v[5] * v[5]) + (v[6] * v[6] + v[7] * v[7]));
                }
                s += __shfl_xor(s, 16); s += __shfl_xor(s, 32);
                if (fq == 0) (void)__hip_atomic_fetch_add(ssq + r, s, __ATOMIC_RELAXED, __HIP_MEMORY_SCOPE_AGENT);
            }
    }
};
struct EpiU {
    static constexpr bool PERM = true;
    bf16_t* U; float* dt; const float* ssq;
    __device__ __forceinline__ void operator()(const f32x4 (&acc)[2][2][4][2], const pg8::Unit& u, int wr, int wc, int fr, int fq) const {
        const int row0 = u.pm * 256 + wr * 64 + fr, col0 = u.pn * 256 + wc * 32 + 8 * fq;
        float sq[2][4];
#pragma unroll
        for (int ai = 0; ai < 2; ++ai)
#pragma unroll
            for (int m = 0; m < 4; ++m) sq[ai][m] = ssq[row0 + ai * 128 + m * 16];
#pragma unroll
        for (int ai = 0; ai < 2; ++ai)
#pragma unroll
            for (int m = 0; m < 4; ++m) {
                const int r = row0 + ai * 128 + m * 16; const float rs = rsqrtf(sq[ai][m] * (1.0f / 1024.0f) + EPS);
#pragma unroll
                for (int bj = 0; bj < 2; ++bj) {
                    const int c = col0 + bj * 128; const f32x4 v0 = acc[ai][bj][m][0] * rs, v1 = acc[ai][bj][m][1] * rs;
                    u32x4 w; w.x = cvt_pk_bf16(v0[0], v0[1]); w.y = cvt_pk_bf16(v0[2], v0[3]); w.z = cvt_pk_bf16(v1[0], v1[1]); w.w = cvt_pk_bf16(v1[2], v1[3]);
                    *(u32x4*)(U + (size_t)r * DINP + c) = w;
                    if (c == DT0) { *(f32x4*)(dt + (size_t)r * 8) = v0; *(f32x4*)(dt + (size_t)r * 8 + 4) = v1; }
                }
            }
    }
};
struct EpiGlu {
    static constexpr bool PERM = true;
    const bf16_t* ys; const float* bias; bf16_t* Y;
    __device__ __forceinline__ void operator()(const f32x4 (&acc)[2][2][4][2], const pg8::Unit& u, int wr, int wc, int fr, int fq) const {
        const int row0 = u.pm * 256 + wr * 64 + fr, col0 = u.pn * 256 + wc * 32 + 8 * fq;
#pragma unroll
        for (int ai = 0; ai < 2; ++ai)
#pragma unroll
            for (int m = 0; m < 4; ++m) {
                const int r = row0 + ai * 128 + m * 16;
#pragma unroll
                for (int bj = 0; bj < 2; ++bj) {
                    const int c = col0 + bj * 128;
                    const u32x4 yv = *(const u32x4*)(ys + (size_t)r * 256 + c);
                    const f32x4 b0 = *(const f32x4*)(bias + c), b1 = *(const f32x4*)(bias + c + 4);
                    const f32x4 a0 = acc[ai][bj][m][0] + b0, a1 = acc[ai][bj][m][1] + b1;
                    float o[8];
                    o[0] = bflo(yv.x) * sigmoidf_(a0[0]); o[1] = bfhi(yv.x) * sigmoidf_(a0[1]); o[2] = bflo(yv.y) * sigmoidf_(a0[2]); o[3] = bfhi(yv.y) * sigmoidf_(a0[3]);
                    o[4] = bflo(yv.z) * sigmoidf_(a1[0]); o[5] = bfhi(yv.z) * sigmoidf_(a1[1]); o[6] = bflo(yv.w) * sigmoidf_(a1[2]); o[7] = bfhi(yv.w) * sigmoidf_(a1[3]);
                    u32x4 w; w.x = cvt_pk_bf16(o[0], o[1]); w.y = cvt_pk_bf16(o[2], o[3]); w.z = cvt_pk_bf16(o[4], o[5]); w.w = cvt_pk_bf16(o[6], o[7]);
                    *(u32x4*)(Y + (size_t)r * D + 512 + c) = w;
                }
            }
    }
};

template <bool F16>
__device__ __forceinline__ void transpose_convert(const float* __restrict__ src, int K, int N, int Npad, const float* __restrict__ gain, bf16_t* __restrict__ dst, int mapkind, int& base, int gw, int stride) {
    const int lane = threadIdx.x & 63, tk = K >> 7, ntasks = (Npad >> 6) * tk;
    int first = (gw - base) % stride; if (first < 0) first += stride;
    base += ntasks;
    for (int ti = first; ti < ntasks; ti += stride) {
        const int k0 = (ti % tk) << 7, n = ((ti / tk) << 6) + lane;
        const bool ok = n < N;
        const int row = mapkind == 0 ? n : ((n >> 7) * 256 + (n & 127) + (mapkind == 2 ? 128 : 0));
        const float* sp = src + (size_t)k0 * N + (ok ? n : 0);
        bf16_t* dp = dst + (size_t)row * K + k0;
#pragma unroll 2
        for (int kk = 0; kk < 128; kk += 16) {
            float v[16];
#pragma unroll
            for (int i = 0; i < 16; ++i) v[i] = sp[(size_t)(kk + i) * N];
            if (gain) {
#pragma unroll
                for (int i = 0; i < 16; i += 4) { const f32x4 gq = *(const f32x4*)(gain + k0 + kk + i); v[i] *= gq[0]; v[i + 1] *= gq[1]; v[i + 2] *= gq[2]; v[i + 3] *= gq[3]; }
            }
            if (!ok) {
#pragma unroll
                for (int i = 0; i < 16; ++i) v[i] = 0.f;
            }
            u32x4 w0, w1;
            if (F16) {
                w0.x = cvt_pk_f16(v[0], v[1]); w0.y = cvt_pk_f16(v[2], v[3]); w0.z = cvt_pk_f16(v[4], v[5]); w0.w = cvt_pk_f16(v[6], v[7]);
                w1.x = cvt_pk_f16(v[8], v[9]); w1.y = cvt_pk_f16(v[10], v[11]); w1.z = cvt_pk_f16(v[12], v[13]); w1.w = cvt_pk_f16(v[14], v[15]);
            } else {
                w0.x = cvt_pk_bf16(v[0], v[1]); w0.y = cvt_pk_bf16(v[2], v[3]); w0.z = cvt_pk_bf16(v[4], v[5]); w0.w = cvt_pk_bf16(v[6], v[7]);
                w1.x = cvt_pk_bf16(v[8], v[9]); w1.y = cvt_pk_bf16(v[10], v[11]); w1.z = cvt_pk_bf16(v[12], v[13]); w1.w = cvt_pk_bf16(v[14], v[15]);
            }
            *(u32x4*)(dp + kk) = w0; *(u32x4*)(dp + kk + 8) = w1;
        }
    }
}
__device__ __forceinline__ void prologue(KP p, LAS unsigned char* lds) {
    bf16_t* W = (bf16_t*)(p->ws + WS_W);
    const int gw = blockIdx.x * 8 + (threadIdx.x >> 6), stride = gridDim.x * 8;
    int base = 0;
    for (int L = 0; L < 2; ++L) {
        bf16_t* WL = W + (size_t)L * LW;
        const size_t offFF = (size_t)L * D * FF;
        transpose_convert<true>(p->in[I_F1G] + offFF, D, FF, FF, p->in[I_F1N] + L * D, WL + LW_GU1, 1, base, gw, stride);
        transpose_convert<true>(p->in[I_F1U] + offFF, D, FF, FF, p->in[I_F1N] + L * D, WL + LW_GU1, 2, base, gw, stride);
        transpose_convert<false>(p->in[I_F1D] + offFF, FF, D, D, nullptr, WL + LW_D1, 0, base, gw, stride);
        transpose_convert<true>(p->in[I_WIN] + (size_t)L * D * 2696, D, 2696, DINP, p->in[I_MN] + L * D, WL + LW_IN, 0, base, gw, stride);
        transpose_convert<false>(p->in[I_WOUT] + (size_t)L * D * D, D, D, D, nullptr, WL + LW_OUT, 0, base, gw, stride);
        transpose_convert<true>(p->in[I_F2G] + offFF, D, FF, FF, p->in[I_F2N] + L * D, WL + LW_GU2, 1, base, gw, stride);
        transpose_convert<true>(p->in[I_F2U] + offFF, D, FF, FF, p->in[I_F2N] + L * D, WL + LW_GU2, 2, base, gw, stride);
        transpose_convert<false>(p->in[I_F2D] + offFF, FF, D, D, nullptr, WL + LW_D2, 0, base, gw, stride);
        transpose_convert<false>(p->in[I_SGW] + (size_t)L * 65536, 256, 256, 256, nullptr, WL + LW_GLU, 0, base, gw, stride);
    }
    const int wid = threadIdx.x >> 6, lane = threadIdx.x & 63;
    const float* x = p->in[I_X]; bf16_t* xb = (bf16_t*)(p->ws + WS_XB); float* ssq = (float*)(p->ws + WS_SSQ);
    for (int r = blockIdx.x * 8 + wid; r < T; r += gridDim.x * 8) {
        float s = 0.f;
#pragma unroll
        for (int i = 0; i < 4; ++i) {
            const size_t off = (size_t)r * D + i * 256 + lane * 4;
            const f32x4 v = *(const f32x4*)(x + off);
            u32x2 w; w.x = cvt_pk_f16(v[0], v[1]); w.y = cvt_pk_f16(v[2], v[3]); *(u32x2*)(xb + off) = w;
            s += (v[0] * v[0] + v[1] * v[1]) + (v[2] * v[2] + v[3] * v[3]);
        }
        s = wave_sum64(s);
        if (lane == 0) { ssq[r] = s; ssq[T + r] = 0.f; }
    }
}
__device__ __forceinline__ void final_norm(KP p) {
    const int wid = threadIdx.x >> 6, lane = threadIdx.x & 63;
    float* out = p->out; const bf16_t* xb = (const bf16_t*)(p->ws + WS_XB); const float* ssq = (const float*)(p->ws + WS_SSQ); const float* g = p->in[I_FN];
    for (int r = blockIdx.x * 8 + wid; r < T; r += gridDim.x * 8) {
        const float rs = row_rstd(ssq, r);
#pragma unroll
        for (int i = 0; i < 4; ++i) {
            const size_t off = (size_t)r * D + i * 256 + lane * 4;
            const u32x2 xw = *(const u32x2*)(xb + off); const f32x4 gv = *(const f32x4*)(g + i * 256 + lane * 4);
            f32x4 v = (f32x4){f16lo(xw.x), f16hi(xw.x), f16lo(xw.y), f16hi(xw.y)};
            v = v * rs * gv; *(f32x4*)(out + off) = v;
        }
    }
}

__device__ __forceinline__ int sw_off(int row, int k) { return row * 256 + ((((k >> 3) ^ (row & 15)) << 4) | ((k & 7) << 1)); }
__device__ __forceinline__ bf16x8 sw_frag(const LAS unsigned char* base, int r0, int ks, int lane) {
    const int row = r0 + (lane & 15), kg = 4 * ks + (lane >> 4);
    return *(const LAS bf16x8*)(base + row * 256 + ((kg ^ (row & 15)) << 4));
}
__device__ __forceinline__ int sw_off2(int row, int k) { return row * 256 + ((((k >> 3) ^ ((row ^ (row >> 3)) & 15)) << 4) | ((k & 7) << 1)); }
__device__ __forceinline__ bf16x8 sw_frag2(const LAS unsigned char* base, int r0, int ks, int lane) {
    const int row = r0 + (lane & 15), kg = 4 * ks + (lane >> 4);
    return *(const LAS bf16x8*)(base + row * 256 + ((kg ^ ((row ^ (row >> 3)) & 15)) << 4));
}
#define MFMA16(a, b, c) __builtin_amdgcn_mfma_f32_16x16x32_bf16((a), (b), (c), 0, 0, 0)

__device__ __forceinline__ void rwkv_prep_phase(KP p, int L, LAS unsigned char* lds) {
    const int tid = threadIdx.x, wid = tid >> 6, lane = tid & 63, h = wid & 3, sub = wid >> 2;
    const bf16_t* U = (const bf16_t*)(p->ws + WS_ACT); float* PF = p->out; bf16_t* PH = (bf16_t*)(p->ws + WS_Y);
    LAS float* M = (LAS float*)lds + wid * 1024;
    const int pc = lane * 4;
    int ucol;
    if (pc < 64) ucol = UR0 + h * 64 + pc; else if (pc < 128) ucol = UR0 + 256 + h * 64 + (pc - 64); else if (pc < 192) ucol = UR0 + 512 + h * 64 + (pc - 128);
    else if (pc < 224) ucol = UR0 + 768 + (pc - 192); else ucol = UR0 + 800 + (pc - 224);
    const bool istanh = (pc >= 192 && pc < 224);
    float mu4[4]; f32x2 w2p[16], a2p[16];
#pragma unroll
    for (int i = 0; i < 4; ++i) mu4[i] = p->in[I_RMU][L * 896 + (ucol - UR0) + i];
    const int ch = h * 64 + lane;
#pragma unroll
    for (int j = 0; j < 16; ++j) { w2p[j] = (f32x2){p->in[I_RW2][(L * 32 + 2 * j) * 256 + ch], p->in[I_RW2][(L * 32 + 2 * j + 1) * 256 + ch]}; a2p[j] = (f32x2){p->in[I_RA2][(L * 32 + 2 * j) * 256 + ch], p->in[I_RA2][(L * 32 + 2 * j + 1) * 256 + ch]}; }
    const float w0c = p->in[I_RW0][L * 256 + ch], a0c = p->in[I_RA0][L * 256 + ch], kkc = p->in[I_RKK][L * 256 + ch], kac = p->in[I_RKA][L * 256 + ch];
    const int nrun = T / 4, rstride = gridDim.x * 2;
    int run = blockIdx.x * 2 + sub;
    u32x2 nv[5];
    if (run < nrun) {
        const int t0 = run * 4; const bf16_t* up = U + (size_t)t0 * DINP + ucol;
        if ((t0 & (SEQ - 1)) == 0) nv[0] = (u32x2){0u, 0u}; else nv[0] = *(const u32x2*)(up - DINP);
#pragma unroll
        for (int i = 0; i < 4; ++i) nv[1 + i] = *(const u32x2*)(up + (size_t)i * DINP);
    }
    for (; run < nrun; run += rstride) {
        u32x2 cv[5];
#pragma unroll
        for (int i = 0; i < 5; ++i) cv[i] = nv[i];
        const int t0 = run * 4, bb = t0 >> 11, ts = t0 & (SEQ - 1);
        if (run + rstride < nrun) {
            const int t1 = (run + rstride) * 4; const bf16_t* up = U + (size_t)t1 * DINP + ucol;
            if ((t1 & (SEQ - 1)) == 0) nv[0] = (u32x2){0u, 0u}; else nv[0] = *(const u32x2*)(up - DINP);
#pragma unroll
            for (int i = 0; i < 4; ++i) nv[1 + i] = *(const u32x2*)(up + (size_t)i * DINP);
        }
#pragma unroll
        for (int i = 0; i < 4; ++i) {
            const u32x2 pv = cv[i], cc = cv[i + 1];
            const float c0 = bflo(cc.x), c1 = bfhi(cc.x), c2 = bflo(cc.y), c3 = bfhi(cc.y);
            const float p0 = bflo(pv.x), p1 = bfhi(pv.x), p2 = bflo(pv.y), p3 = bfhi(pv.y);
            f32x4 m; m[0] = c0 + (p0 - c0) * mu4[0]; m[1] = c1 + (p1 - c1) * mu4[1]; m[2] = c2 + (p2 - c2) * mu4[2]; m[3] = c3 + (p3 - c3) * mu4[3];
            *(LAS f32x4*)(M + i * 256 + pc) = m;
        }
#pragma unroll
        for (int k2 = 0; k2 < 2; ++k2) { LAS float* pm_ = M + ((lane >> 5) + 2 * k2) * 256 + 192 + (lane & 31); *pm_ = tanhf_(*pm_); }
        const size_t drow = ((size_t)(bb * 4 + h) * SEQ + ts) * 192;
#pragma unroll 2
        for (int i = 0; i < 4; ++i) {
            const LAS float* Mi = M + i * 256;
            const float xr = Mi[lane], xk = Mi[64 + lane], xv = Mi[128 + lane];
            f32x2 wac2 = (f32x2){w0c, 0.f}, aac2 = (f32x2){a0c, 0.f};
#pragma unroll
            for (int j = 0; j < 32; j += 4) {
                const f32x4 wl = *(const LAS f32x4*)(Mi + 192 + j), al = *(const LAS f32x4*)(Mi + 224 + j);
                wac2 = (f32x2){wl[0], wl[1]} * w2p[j >> 1] + wac2; wac2 = (f32x2){wl[2], wl[3]} * w2p[(j >> 1) + 1] + wac2;
                aac2 = (f32x2){al[0], al[1]} * a2p[j >> 1] + aac2; aac2 = (f32x2){al[2], al[3]} * a2p[(j >> 1) + 1] + aac2;
            }
            const float wacc = wac2[0] + wac2[1], aacc = aac2[0] + aac2[1];
            const float dec = __expf(-0.60653065971f * sigmoidf_(wacc));
            const float a = sigmoidf_(aacc);
            const float kkr = xk * kkc; const float ss = wave_sum64_dpp(kkr * kkr);
            const float kk = kkr * rsqrtf(fmaxf(ss, 1e-24f));
            const float kp = xk * (1.0f + (a - 1.0f) * kac);
            float* df = PF + drow + (size_t)i * 192; bf16_t* dh = PH + drow + (size_t)i * 192;
            df[lane] = dec; df[64 + lane] = kk; df[128 + lane] = kk * a;
            dh[lane] = f2bf(xr); dh[64 + lane] = f2bf(kp); dh[128 + lane] = f2bf(xv);
        }
    }
}

__device__ __forceinline__ float dpp_f(float v, int ctrl_sel) {
    int x;
    if (ctrl_sel == 0) x = __builtin_amdgcn_update_dpp(0, __float_as_int(v), 0xB1, 0xF, 0xF, true);
    else if (ctrl_sel == 1) x = __builtin_amdgcn_update_dpp(0, __float_as_int(v), 0x4E, 0xF, 0xF, true);
    else if (ctrl_sel == 2) x = __builtin_amdgcn_update_dpp(0, __float_as_int(v), 0x124, 0xF, 0xF, true);
    else x = __builtin_amdgcn_update_dpp(0, __float_as_int(v), 0x128, 0xF, 0xF, true);
    return __int_as_float(x);
}
__device__ __forceinline__ float row16_reduce4(float p0, float p1, float p2, float p3, bool odd1, bool odd2) {
    const float ka = odd1 ? p1 : p0, sa_ = odd1 ? p0 : p1, kb = odd1 ? p3 : p2, sb_ = odd1 ? p2 : p3;
    const float a_ = ka + dpp_f(sa_, 0), b_ = kb + dpp_f(sb_, 0);
    const float kc = odd2 ? b_ : a_, sc_ = odd2 ? a_ : b_;
    float c_ = kc + dpp_f(sc_, 1);
    c_ += dpp_f(c_, 2); c_ += dpp_f(c_, 3);
    return c_;
}
__device__ __forceinline__ void rwkv_unit(KP p, int L, LAS unsigned char* lds, int unit) {
    const int tid = threadIdx.x, wid = tid >> 6, lane = tid & 63;
    const int b = unit >> 3, h = (unit >> 1) & 3, half = unit & 1;
    bf16_t* yr = (bf16_t*)(p->ws + WS_YR);
    const unsigned char* PF = (const unsigned char*)p->out + (size_t)(b * 4 + h) * SEQ * 768; const unsigned char* PH = p->ws + WS_Y + (size_t)(b * 4 + h) * SEQ * 384;
    const size_t tb = (size_t)b * SEQ;
    LAS float* CBUF = (LAS float*)lds;
    f32x2 Sa = (f32x2){0.f, 0.f}, Sb = Sa, Sc = Sa, Sd = Sa;
    const int row = half * 32 + (wid & 3) * 8 + (lane >> 4), q = lane & 15, lt = tid - 256;
    for (int ck = -1; ck < 64; ++ck) {
        if (wid >= 4) {
            const int cn = ck + 1;
            if (cn < 64) {
                const unsigned char* srcf = PF + (size_t)cn * 32 * 768; const unsigned char* srch = PH + (size_t)cn * 32 * 384;
                LAS float* CB = CBUF + (cn & 1) * (32 * 384);
                u32x4 v[9];
#pragma unroll
                for (int j = 0; j < 6; ++j) v[j] = *(const u32x4*)(srcf + (size_t)(lt + 256 * j) * 16);
#pragma unroll
                for (int j = 0; j < 3; ++j) v[6 + j] = *(const u32x4*)(srch + (size_t)(lt + 256 * j) * 16);
#pragma unroll
                for (int j = 0; j < 6; ++j) { const int i = lt + 256 * j, tt = i / 48, off = i - tt * 48; *(LAS u32x4*)(CB + tt * 384 + off * 4) = v[j]; }
#pragma unroll
                for (int j = 0; j < 3; ++j) {
                    const int i = lt + 256 * j, tt = i / 24, o2 = i - tt * 24; LAS float* d = CB + tt * 384 + (3 + (o2 >> 3)) * 64 + (o2 & 7) * 8;
                    *(LAS f32x4*)d = (f32x4){bflo(v[6 + j].x), bfhi(v[6 + j].x), bflo(v[6 + j].y), bfhi(v[6 + j].y)};
                    *(LAS f32x4*)(d + 4) = (f32x4){bflo(v[6 + j].z), bfhi(v[6 + j].z), bflo(v[6 + j].w), bfhi(v[6 + j].w)};
                }
            }
        } else if (ck >= 0) {
            const LAS float* ct = CBUF + (ck & 1) * (32 * 384) + 4 * q;
            const LAS float* cvp = CBUF + (ck & 1) * (32 * 384) + 320 + row;
            bf16_t* yo = yr + (tb + (size_t)ck * 32) * 256 + h * 64 + row;
            f32x4 w4 = *(const LAS f32x4*)(ct), kk4 = *(const LAS f32x4*)(ct + 64), ka4 = *(const LAS f32x4*)(ct + 128), r4 = *(const LAS f32x4*)(ct + 192), k4 = *(const LAS f32x4*)(ct + 256);
            float vA = cvp[0], vB = cvp[4];
            float ykA = 0.f, ykB = 0.f; float ypA[4] = {0.f, 0.f, 0.f, 0.f}, ypB[4] = {0.f, 0.f, 0.f, 0.f};
            const bool odd1 = (q & 1) != 0, odd2 = (q & 2) != 0;
#pragma unroll
            for (int tt = 0; tt < 32; ++tt) {
                const int tn = (tt + 1 < 32) ? tt + 1 : tt;
                const f32x4 nw4 = *(const LAS f32x4*)(ct + tn * 384), nkk4 = *(const LAS f32x4*)(ct + tn * 384 + 64), nka4 = *(const LAS f32x4*)(ct + tn * 384 + 128);
                const f32x4 nr4 = *(const LAS f32x4*)(ct + tn * 384 + 192), nk4 = *(const LAS f32x4*)(ct + tn * 384 + 256); const float nvA = cvp[tn * 384], nvB = cvp[tn * 384 + 4];
                const f32x2 kkA = (f32x2){kk4[0], kk4[1]}, kkB = (f32x2){kk4[2], kk4[3]}, kaA = (f32x2){ka4[0], ka4[1]}, kaB = (f32x2){ka4[2], ka4[3]};
                const f32x2 kA = (f32x2){k4[0], k4[1]}, kB = (f32x2){k4[2], k4[3]}, wA = (f32x2){w4[0], w4[1]}, wB = (f32x2){w4[2], w4[3]}, rA = (f32x2){r4[0], r4[1]}, rB = (f32x2){r4[2], r4[3]};
                f32x2 t1 = Sa * kkA; t1 = Sb * kkB + t1;
                f32x2 t2 = Sc * kkA; t2 = Sd * kkB + t2;
                const float sa1 = -dpp_row_sum16(t1[0] + t1[1]);
                const float sa2 = -dpp_row_sum16(t2[0] + t2[1]);
                const f32x2 s1 = (f32x2){sa1, sa1}, v1 = (f32x2){vA, vA}, s2 = (f32x2){sa2, sa2}, v2 = (f32x2){vB, vB};
                Sa = Sa * wA + (s1 * kaA + v1 * kA); Sb = Sb * wB + (s1 * kaB + v1 * kB);
                Sc = Sc * wA + (s2 * kaA + v2 * kA); Sd = Sd * wB + (s2 * kaB + v2 * kB);
                f32x2 y1 = Sa * rA; y1 = Sb * rB + y1;
                f32x2 y2 = Sc * rA; y2 = Sd * rB + y2;
                ypA[tt & 3] = y1[0] + y1[1]; ypB[tt & 3] = y2[0] + y2[1];
                if ((tt & 3) == 3) {
                    const float yA = row16_reduce4(ypA[0], ypA[1], ypA[2], ypA[3], odd1, odd2);
                    const float yB = row16_reduce4(ypB[0], ypB[1], ypB[2], ypB[3], odd1, odd2);
                    const bool mine = (q >> 2) == ((tt >> 2) & 3);
                    ykA = mine ? yA : ykA; ykB = mine ? yB : ykB;
                }
                if ((tt & 15) == 15) { yo[(size_t)((tt & 16) + q) * 256] = f2bf(ykA); yo[(size_t)((tt & 16) + q) * 256 + 4] = f2bf(ykB); }
                w4 = nw4; kk4 = nkk4; ka4 = nka4; r4 = nr4; k4 = nk4; vA = nvA; vB = nvB;
            }
        }
        __syncthreads();
    }
}

struct SsdLds {
    LAS unsigned char *Cs, *Bs, *BT, *XT, *XdT, *StB; LAS float *Acs, *dts;
};
__device__ __forceinline__ SsdLds ssd_lds(LAS unsigned char* lds) {
    SsdLds m; m.Cs = lds; m.Bs = lds + 32768; m.BT = lds + 65536; m.XT = lds + 98304; m.XdT = lds + 114688; m.StB = lds + 131072;
    m.Acs = (LAS float*)(lds + 147456); m.dts = m.Acs + 128; return m;
}
struct SsdConst { float cw[8][4]; float cbias[8]; float Ah, dtbias, Dh; int ch0; };
__device__ __forceinline__ void conv8_silu(const u32x4& h0, const u32x4& h1, const u32x4& h2, const u32x4& h3, const float (&cw)[8][4], const float (&cbias)[8], float (&o)[8]) {
#pragma unroll
    for (int e = 0; e < 8; ++e) {
        const unsigned w0 = e < 2 ? h0.x : e < 4 ? h0.y : e < 6 ? h0.z : h0.w, w1 = e < 2 ? h1.x : e < 4 ? h1.y : e < 6 ? h1.z : h1.w;
        const unsigned w2 = e < 2 ? h2.x : e < 4 ? h2.y : e < 6 ? h2.z : h2.w, w3 = e < 2 ? h3.x : e < 4 ? h3.y : e < 6 ? h3.z : h3.w;
        const float v0 = (e & 1) ? bfhi(w0) : bflo(w0), v1 = (e & 1) ? bfhi(w1) : bflo(w1), v2 = (e & 1) ? bfhi(w2) : bflo(w2), v3 = (e & 1) ? bfhi(w3) : bflo(w3);
        const float sacc = cbias[e] + cw[e][0] * v0 + cw[e][1] * v1 + cw[e][2] * v2 + cw[e][3] * v3;
        o[e] = siluf_(sacc);
    }
}
__device__ __forceinline__ void ssd_bc_prepass(KP p, int L) {
    const int tid = threadIdx.x, cg = tid & 63, run = tid >> 6;
    const bf16_t* U = (const bf16_t*)(p->ws + WS_ACT); bf16_t* BCc = (bf16_t*)(p->ws + WS_BCC);
    float cw[8][4], cbias[8];
#pragma unroll
    for (int i = 0; i < 8; ++i) { const f32x4 w = *(const f32x4*)(p->in[I_MCW] + ((size_t)L * 1024 + 512 + cg * 8 + i) * 4); cw[i][0] = w[0]; cw[i][1] = w[1]; cw[i][2] = w[2]; cw[i][3] = w[3]; cbias[i] = p->in[I_MCB][L * 1024 + 512 + cg * 8 + i]; }
    for (int tile = blockIdx.x; tile < T / 128; tile += gridDim.x) {
        const int ta = tile * 128 + run * 16;
        const bf16_t* up = U + (size_t)ta * DINP + XBC0 + 512 + cg * 8;
        u32x4 hv[19];
#pragma unroll
        for (int i = 0; i < 3; ++i) { if ((ta & (SEQ - 1)) != 0) hv[i] = *(const u32x4*)(up - (3 - i) * DINP); else hv[i] = (u32x4){0u, 0u, 0u, 0u}; }
#pragma unroll
        for (int i = 0; i < 16; ++i) hv[3 + i] = *(const u32x4*)(up + (size_t)i * DINP);
#pragma unroll
        for (int i = 0; i < 16; ++i) {
            float o[8]; conv8_silu(hv[i], hv[i + 1], hv[i + 2], hv[i + 3], cw, cbias, o);
            u32x4 w; w.x = cvt_pk_bf16(o[0], o[1]); w.y = cvt_pk_bf16(o[2], o[3]); w.z = cvt_pk_bf16(o[4], o[5]); w.w = cvt_pk_bf16(o[6], o[7]);
            *(u32x4*)(BCc + (size_t)(ta + i) * 512 + cg * 8) = w;
        }
    }
}
__device__ __forceinline__ void ssd_stage(KP p, const SsdLds& m, const SsdConst& k, int b, int c, int hd, int tid) {
    const bf16_t* U = (const bf16_t*)(p->ws + WS_ACT); const float* dtb = (const float*)(p->ws + WS_DT); const bf16_t* BCc = (const bf16_t*)(p->ws + WS_BCC);
    const int lane = tid & 63, g = hd >> 2;
    const size_t t0 = (size_t)b * SEQ + c * 128;
    const int cgx = tid & 7, ls = (tid >> 3) * 2;
    u32x4 hv[5], bc[8];
    {
        const bf16_t* up = U + (t0 + ls) * DINP + XBC0 + k.ch0;
        const int lbase = c * 128 + ls;
#pragma unroll
        for (int i = 0; i < 3; ++i) { if (lbase - 3 + i >= 0) hv[i] = *(const u32x4*)(up - (3 - i) * DINP); else hv[i] = (u32x4){0u, 0u, 0u, 0u}; }
        hv[3] = *(const u32x4*)up; hv[4] = *(const u32x4*)(up + DINP);
#pragma unroll
        for (int j = 0; j < 8; ++j) { const int i = tid + 512 * j, l = i >> 5, cgb = i & 31; bc[j] = *(const u32x4*)(BCc + (t0 + l) * 512 + (cgb < 16 ? g * 128 + cgb * 8 : 256 + g * 128 + (cgb - 16) * 8)); }
    }
    if (tid >= 480) {
        const int j = lane - 32, l0 = 4 * j;
        float d[4], ac[4];
#pragma unroll
        for (int i = 0; i < 4; ++i) d[i] = softplusf_(dtb[(t0 + l0 + i) * 8 + hd] + k.dtbias);
        ac[0] = d[0] * k.Ah; ac[1] = ac[0] + d[1] * k.Ah; ac[2] = ac[1] + d[2] * k.Ah; ac[3] = ac[2] + d[3] * k.Ah;
        float inc = ac[3];
#pragma unroll
        for (int o = 1; o < 32; o <<= 1) { const float t = __shfl_up(inc, o); if (j >= o) inc += t; }
        const float ex = inc - ac[3];
        *(LAS f32x4*)(m.Acs + l0) = (f32x4){ex + ac[0], ex + ac[1], ex + ac[2], ex + ac[3]};
        *(LAS f32x4*)(m.dts + l0) = (f32x4){d[0], d[1], d[2], d[3]};
    }
#pragma unroll
    for (int i = 0; i < 2; ++i) {
        float o[8]; conv8_silu(hv[i], hv[i + 1], hv[i + 2], hv[i + 3], k.cw, k.cbias, o);
#pragma unroll
        for (int e = 0; e < 8; ++e) *(LAS bf16_t*)(m.XT + sw_off2(cgx * 8 + e, ls + i)) = f2bf(o[e]);
    }
#pragma unroll
    for (int j = 0; j < 8; ++j) {
        const int i = tid + 512 * j, l = i >> 5, cgb = i & 31;
        if (cgb < 16) {
            const int n0 = cgb * 8; const u32x4 w = bc[j];
            *(LAS u32x4*)(m.Bs + sw_off(l, n0)) = w;
            *(LAS bf16_t*)(m.BT + sw_off2(n0 + 0, l)) = (bf16_t)(w.x & 0xffffu); *(LAS bf16_t*)(m.BT + sw_off2(n0 + 1, l)) = (bf16_t)(w.x >> 16);
            *(LAS bf16_t*)(m.BT + sw_off2(n0 + 2, l)) = (bf16_t)(w.y & 0xffffu); *(LAS bf16_t*)(m.BT + sw_off2(n0 + 3, l)) = (bf16_t)(w.y >> 16);
            *(LAS bf16_t*)(m.BT + sw_off2(n0 + 4, l)) = (bf16_t)(w.z & 0xffffu); *(LAS bf16_t*)(m.BT + sw_off2(n0 + 5, l)) = (bf16_t)(w.z >> 16);
            *(LAS bf16_t*)(m.BT + sw_off2(n0 + 6, l)) = (bf16_t)(w.w & 0xffffu); *(LAS bf16_t*)(m.BT + sw_off2(n0 + 7, l)) = (bf16_t)(w.w >> 16);
        } else {
            *(LAS u32x4*)(m.Cs + sw_off(l, (cgb - 16) * 8)) = bc[j];
        }
    }
    __syncthreads();
    {
        const float alast = m.Acs[127];
#pragma unroll
        for (int it = 0; it < 2; ++it) {
            const int i = tid + 512 * it, pp = i >> 4, l0 = (i & 15) * 8;
            const u32x4 xv = *(const LAS u32x4*)(m.XT + sw_off2(pp, l0));
            const f32x4 a0 = *(const LAS f32x4*)(m.Acs + l0), a1 = *(const LAS f32x4*)(m.Acs + l0 + 4), d0 = *(const LAS f32x4*)(m.dts + l0), d1 = *(const LAS f32x4*)(m.dts + l0 + 4);
            u32x4 w;
            w.x = cvt_pk_bf16(bflo(xv.x) * d0[0] * __expf(alast - a0[0]), bfhi(xv.x) * d0[1] * __expf(alast - a0[1]));
            w.y = cvt_pk_bf16(bflo(xv.y) * d0[2] * __expf(alast - a0[2]), bfhi(xv.y) * d0[3] * __expf(alast - a0[3]));
            w.z = cvt_pk_bf16(bflo(xv.z) * d1[0] * __expf(alast - a1[0]), bfhi(xv.z) * d1[1] * __expf(alast - a1[1]));
            w.w = cvt_pk_bf16(bflo(xv.w) * d1[2] * __expf(alast - a1[2]), bfhi(xv.w) * d1[3] * __expf(alast - a1[3]));
            *(LAS u32x4*)(m.XdT + sw_off(pp, l0)) = w;
        }
    }
    __syncthreads();
}
__device__ __forceinline__ void ssd_load_const(KP p, int L, int hd, int tid, SsdConst& k) {
    k.ch0 = hd * 64 + (tid & 7) * 8;
#pragma unroll
    for (int i = 0; i < 8; ++i) { const f32x4 w = *(const f32x4*)(p->in[I_MCW] + ((size_t)L * 1024 + k.ch0 + i) * 4); k.cw[i][0] = w[0]; k.cw[i][1] = w[1]; k.cw[i][2] = w[2]; k.cw[i][3] = w[3]; k.cbias[i] = p->in[I_MCB][L * 1024 + k.ch0 + i]; }
    k.Ah = -__expf(p->in[I_MALOG][L * 8 + hd]); k.dtbias = p->in[I_MDTB][L * 8 + hd]; k.Dh = p->in[I_MD][L * 8 + hd];
}
__device__ __forceinline__ void ssd_passA(KP p, int L, LAS unsigned char* lds, int unit) {
    const int b = unit >> 4, hd = (unit >> 1) & 7, half = unit & 1;
    const SsdLds m = ssd_lds(lds);
    SsdConst k; ssd_load_const(p, L, hd, threadIdx.x, k);
    bf16_t* SL = (bf16_t*)(p->ws + WS_SL); float* DEC = (float*)(p->ws + WS_DEC);
    const int tid0 = threadIdx.x;
    for (int c = half * 4; c < half * 4 + 4; ++c) {
        int tidv = tid0; asm volatile("" : "+v"(tidv));
        const int tid = tidv, lane = tidv & 63, wid = tidv >> 6;
        ssd_stage(p, m, k, b, c, hd, tid);
        f32x4 st[4];
#pragma unroll
        for (int i = 0; i < 4; ++i) st[i] = (f32x4){0.f, 0.f, 0.f, 0.f};
#pragma unroll 1
        for (int ks = 0; ks < 4; ++ks) {
            const bf16x8 bb = sw_frag2(m.BT, 16 * wid, ks, lane);
#pragma unroll
            for (int pt = 0; pt < 4; ++pt) { const bf16x8 a = sw_frag(m.XdT, 16 * pt, ks, lane); st[pt] = MFMA16(bb, a, st[pt]); }
        }
        const int ua = (b * 8 + c) * 8 + hd;
#pragma unroll
        for (int pt = 0; pt < 4; ++pt) { u32x2 w; w.x = cvt_pk_bf16(st[pt][0], st[pt][1]); w.y = cvt_pk_bf16(st[pt][2], st[pt][3]); *(u32x2*)(SL + ((size_t)((ua * 8 + wid) * 4 + pt) * 64 + lane) * 4) = w; }
        if (tid == 0) DEC[ua] = __expf(m.Acs[127]);
        __syncthreads();
    }
}
__device__ __forceinline__ void ssd_passB(KP p, int L, LAS unsigned char* lds, int unit, bool whole) {
    const int b = unit >> 4, hd = (unit >> 1) & 7, half = whole ? 0 : (unit & 1);
    const int c_begin = half * 8, c_end = whole ? 16 : half * 8 + 8;
    const SsdLds m = ssd_lds(lds);
    SsdConst k; ssd_load_const(p, L, hd, threadIdx.x, k);
    bf16_t* ym = (bf16_t*)(p->ws + WS_YM);
    const bf16_t* SL = (const bf16_t*)(p->ws + WS_SL); const float* DEC = (const float*)(p->ws + WS_DEC);
    f32x4 st[4];
#pragma unroll
    for (int i = 0; i < 4; ++i) st[i] = (f32x4){0.f, 0.f, 0.f, 0.f};
    {
        const int lane = threadIdx.x & 63, wid = threadIdx.x >> 6, q4 = lane >> 4, c16 = lane & 15;
        if (half == 1) {
#pragma unroll
            for (int cp = 0; cp < 8; ++cp) {
                const int ua = (b * 8 + cp) * 8 + hd; const float dc = DEC[ua];
#pragma unroll
                for (int pt = 0; pt < 4; ++pt) {
                    const u32x2 w = *(const u32x2*)(SL + ((size_t)((ua * 8 + wid) * 4 + pt) * 64 + lane) * 4);
                    st[pt][0] = st[pt][0] * dc + bflo(w.x); st[pt][1] = st[pt][1] * dc + bfhi(w.x); st[pt][2] = st[pt][2] * dc + bflo(w.y); st[pt][3] = st[pt][3] * dc + bfhi(w.y);
                }
            }
        }
#pragma unroll
        for (int pt = 0; pt < 4; ++pt)
            { u32x2 w2; w2.x = cvt_pk_bf16(st[pt][0], st[pt][1]); w2.y = cvt_pk_bf16(st[pt][2], st[pt][3]); *(LAS u32x2*)(m.StB + sw_off(16 * pt + c16, 16 * wid + 4 * q4)) = w2; }
    }
    __syncthreads();
    const int tid0 = threadIdx.x;
    for (int c = c_begin; c < c_end; ++c) {
        int tidv = tid0; asm volatile("" : "+v"(tidv));
        const int tid = tidv, lane = tidv & 63, wid = tidv >> 6, q4 = lane >> 4, c16 = lane & 15;
        const size_t t0 = (size_t)b * SEQ + c * 128;
        ssd_stage(p, m, k, b, c, hd, tid);
        f32x4 yo[4], cb[8];
#pragma unroll
        for (int i = 0; i < 4; ++i) yo[i] = (f32x4){0.f, 0.f, 0.f, 0.f};
#pragma unroll
        for (int i = 0; i < 8; ++i) cb[i] = (f32x4){0.f, 0.f, 0.f, 0.f};
#pragma unroll 1
        for (int ks = 0; ks < 4; ++ks) {
            const bf16x8 a = sw_frag(m.Cs, 16 * wid, ks, lane);
#pragma unroll
            for (int pt = 0; pt < 4; ++pt) { const bf16x8 bb = sw_frag(m.StB, 16 * pt, ks, lane); yo[pt] = MFMA16(a, bb, yo[pt]); }
#pragma unroll
            for (int s8 = 0; s8 < 8; ++s8) { const bf16x8 bb = sw_frag(m.Bs, 16 * s8, ks, lane); cb[s8] = MFMA16(bb, a, cb[s8]); }
        }
        __syncthreads();
        {
            const int l = 16 * wid + c16; const float al = m.Acs[l];
#pragma unroll
            for (int s8 = 0; s8 < 8; ++s8) {
                const int s0 = 16 * s8 + 4 * q4;
                const f32x4 as4 = *(const LAS f32x4*)(m.Acs + s0), ds4 = *(const LAS f32x4*)(m.dts + s0);
                float gv[4];
#pragma unroll
                for (int j = 0; j < 4; ++j) gv[j] = (s0 + j <= l) ? cb[s8][j] * __expf(al - as4[j]) * ds4[j] : 0.f;
                u32x2 w2; w2.x = cvt_pk_bf16(gv[0], gv[1]); w2.y = cvt_pk_bf16(gv[2], gv[3]);
                *(LAS u32x2*)(m.Bs + sw_off(l, s0)) = w2;
            }
        }
        __syncthreads();
        {
            f32x4 yd[4];
#pragma unroll
            for (int i = 0; i < 4; ++i) yd[i] = (f32x4){0.f, 0.f, 0.f, 0.f};
#pragma unroll 2
            for (int ks = 0; ks < 4; ++ks) {
                const bf16x8 a = sw_frag(m.Bs, 16 * wid, ks, lane);
#pragma unroll
                for (int pt = 0; pt < 4; ++pt) { const bf16x8 bb = sw_frag2(m.XT, 16 * pt, ks, lane); yd[pt] = MFMA16(a, bb, yd[pt]); }
            }
#pragma unroll
            for (int j = 0; j < 4; ++j) {
                const int l = 16 * wid + 4 * q4 + j; const float ea = __expf(m.Acs[l]);
#pragma unroll
                for (int pt = 0; pt < 4; ++pt) {
                    const int pp = 16 * pt + c16;
                    const float xs = bf2f(*(const LAS bf16_t*)(m.XT + sw_off2(pp, l)));
                    ym[(t0 + l) * 512 + hd * 64 + pp] = f2bf(yd[pt][j] + ea * yo[pt][j] + k.Dh * xs);
                }
            }
            const float el = __expf(m.Acs[127]);
#pragma unroll
            for (int pt = 0; pt < 4; ++pt) st[pt] = st[pt] * el;
#pragma unroll 2
            for (int ks = 0; ks < 4; ++ks) {
                const bf16x8 bb = sw_frag2(m.BT, 16 * wid, ks, lane);
#pragma unroll
                for (int pt = 0; pt < 4; ++pt) { const bf16x8 a = sw_frag(m.XdT, 16 * pt, ks, lane); st[pt] = MFMA16(bb, a, st[pt]); }
            }
        }
        __syncthreads();
#pragma unroll
        for (int pt = 0; pt < 4; ++pt)
            { u32x2 w2; w2.x = cvt_pk_bf16(st[pt][0], st[pt][1]); w2.y = cvt_pk_bf16(st[pt][2], st[pt][3]); *(LAS u32x2*)(m.StB + sw_off(16 * pt + c16, 16 * wid + 4 * q4)) = w2; }
    }
    __syncthreads();
}

__device__ __forceinline__ void s5_unit(KP p, int L, LAS unsigned char* lds, int unit) {
    const int tid = threadIdx.x, wid = tid >> 6, lane = tid & 63, q4 = lane >> 4, c16 = lane & 15;
    const int b = unit >> 4, g = unit & 15;
    const bf16_t* U = (const bf16_t*)(p->ws + WS_ACT); bf16_t* ys = (bf16_t*)(p->ws + WS_YS);
    LAS unsigned char* Xs = lds;
    LAS float* Uf0 = (LAS float*)(lds + 65536);
    LAS float* E = (LAS float*)(lds + 65536 + 32768);
    const int pidx = lane, lg = wid;
    const float dt = __expf(p->in[I_SLDT][L * 16 + g]);
    const float Are = p->in[I_SARE][(L * 16 + g) * 64 + pidx], Aim = p->in[I_SAIM][(L * 16 + g) * 64 + pidx];
    const float mag = __expf(Are * dt); float sn, cs; sincosf(Aim * dt, &sn, &cs);
    const float abr = mag * cs, abi = mag * sn;
    const float den = Are * Are + Aim * Aim, nr = abr - 1.0f, ni = abi;
    const float cre = (nr * Are + ni * Aim) / den, cim = (ni * Are - nr * Aim) / den;
    f32x2 Bb[16];
#pragma unroll
    for (int h4 = 0; h4 < 16; h4 += 4) {
        const f32x4 br = *(const f32x4*)(p->in[I_SBRE] + ((size_t)(L * 16 + g) * 64 + pidx) * 16 + h4), bi = *(const f32x4*)(p->in[I_SBIM] + ((size_t)(L * 16 + g) * 64 + pidx) * 16 + h4);
#pragma unroll
        for (int e = 0; e < 4; ++e) { Bb[h4 + e] = (f32x2){cre * br[e] - cim * bi[e], cre * bi[e] + cim * br[e]}; }
    }
    float a32r = abr, a32i = abi;
#pragma unroll
    for (int i = 0; i < 5; ++i) { const float nr_ = a32r * a32r - a32i * a32i, ni_ = 2.0f * a32r * a32i; a32r = nr_; a32i = ni_; }
    bf16x8 cfrag[4];
#pragma unroll
    for (int ks = 0; ks < 4; ++ks) {
        const float* src = (ks < 2 ? p->in[I_SCRE] : p->in[I_SCIM]) + ((size_t)(L * 16 + g) * 16 + c16) * 64 + (32 * ks + 8 * q4) % 64;
        const f32x4 v0 = *(const f32x4*)src, v1 = *(const f32x4*)(src + 4); const float sg = ks < 2 ? 1.0f : -1.0f;
        union { u32x4 u; bf16x8 h; } cv;
        cv.u.x = cvt_pk_bf16(sg * v0[0], sg * v0[1]); cv.u.y = cvt_pk_bf16(sg * v0[2], sg * v0[3]); cv.u.z = cvt_pk_bf16(sg * v1[0], sg * v1[1]); cv.u.w = cvt_pk_bf16(sg * v1[2], sg * v1[3]);
        cfrag[ks] = cv.h;
    }
    const float dsk = p->in[I_SD][L * 256 + g * 16 + c16];
    float car = 0.f, cai = 0.f;
    const size_t tb = (size_t)b * SEQ;
    u32x4 unext;
    { const int l = tid >> 1, h8 = (tid & 1) * 8; unext = *(const u32x4*)(U + (tb + l) * DINP + US0 + g * 16 + h8); *(LAS f32x4*)(Uf0 + l * 16 + h8) = (f32x4){bflo(unext.x), bfhi(unext.x), bflo(unext.y), bfhi(unext.y)}; *(LAS f32x4*)(Uf0 + l * 16 + h8 + 4) = (f32x4){bflo(unext.z), bfhi(unext.z), bflo(unext.w), bfhi(unext.w)}; }
    __syncthreads();
    const int tid0 = tid;
    for (int c = 0; c < 8; ++c) {
        int tidv = tid0; asm volatile("" : "+v"(tidv));
        const int tid = tidv, lane = tidv & 63, wid = tidv >> 6, q4 = lane >> 4, c16 = lane & 15, pidx = lane, lg = wid;
        const size_t t0 = tb + c * 256;
        LAS float* Uf = Uf0 + (c & 1) * 4096;
        if (c + 1 < 8) { const int l = tid >> 1, h8 = (tid & 1) * 8; unext = *(const u32x4*)(U + (t0 + 256 + l) * DINP + US0 + g * 16 + h8); }
        float xr[32], xi[32]; float sr = 0.f, si = 0.f;
#pragma unroll
        for (int i = 0; i < 32; ++i) {
            const LAS float* ul = Uf + (lg * 32 + i) * 16;
            f32x2 bacc = (f32x2){0.f, 0.f}, bacc2 = (f32x2){0.f, 0.f};
#pragma unroll
            for (int h4 = 0; h4 < 16; h4 += 4) { const f32x4 uv = *(const LAS f32x4*)(ul + h4);
                bacc = (f32x2){uv[0], uv[0]} * Bb[h4] + bacc; bacc2 = (f32x2){uv[1], uv[1]} * Bb[h4 + 1] + bacc2;
                bacc = (f32x2){uv[2], uv[2]} * Bb[h4 + 2] + bacc; bacc2 = (f32x2){uv[3], uv[3]} * Bb[h4 + 3] + bacc2; }
            bacc = bacc + bacc2;
            const float nr2 = abr * sr - abi * si + bacc[0], ni2 = abr * si + abi * sr + bacc[1]; sr = nr2; si = ni2; xr[i] = sr; xi[i] = si;
        }
        E[(lg * 64 + pidx) * 2] = sr; E[(lg * 64 + pidx) * 2 + 1] = si;
        __syncthreads();
        float cr = car, ci = cai, cinr = 0.f, cini = 0.f;
#pragma unroll
        for (int j = 0; j < 8; ++j) {
            if (j == lg) { cinr = cr; cini = ci; }
            const float er = E[(j * 64 + pidx) * 2], ei = E[(j * 64 + pidx) * 2 + 1];
            const float nr2 = a32r * cr - a32i * ci + er, ni2 = a32r * ci + a32i * cr + ei; cr = nr2; ci = ni2;
        }
        car = cr; cai = ci;
        float cpr = cinr, cpi = cini;
#pragma unroll
        for (int i = 0; i < 32; ++i) {
            { const float nr_ = cpr * abr - cpi * abi, ni_ = cpr * abi + cpi * abr; cpr = nr_; cpi = ni_; }
            const float fr = xr[i] + cpr, fi = xi[i] + cpi;
            const int l = lg * 32 + i;
            *(LAS bf16_t*)(Xs + sw_off(l, pidx)) = f2bf(fr); *(LAS bf16_t*)(Xs + sw_off(l, 64 + pidx)) = f2bf(fi);
        }
        __syncthreads();
#pragma unroll
        for (int mt = 0; mt < 2; ++mt) {
            f32x4 acc = (f32x4){0.f, 0.f, 0.f, 0.f};
#pragma unroll
            for (int ks = 0; ks < 4; ++ks) { const bf16x8 a = sw_frag(Xs, 16 * (wid + 8 * mt), ks, lane); acc = MFMA16(a, cfrag[ks], acc); }
#pragma unroll
            for (int j = 0; j < 4; ++j) {
                const int l = 16 * (wid + 8 * mt) + 4 * q4 + j;
                const float y = acc[j] + dsk * Uf[l * 16 + c16];
                const float ge = 0.5f * y * (1.0f + tanhf_(0.7978845608f * (y + 0.044715f * y * y * y)));
                ys[(t0 + l) * 256 + g * 16 + c16] = f2bf(ge);
            }
        }
        if (c + 1 < 8) { const int l = tid >> 1, h8 = (tid & 1) * 8; LAS float* Un = Uf0 + ((c + 1) & 1) * 4096; *(LAS f32x4*)(Un + l * 16 + h8) = (f32x4){bflo(unext.x), bfhi(unext.x), bflo(unext.y), bfhi(unext.y)}; *(LAS f32x4*)(Un + l * 16 + h8 + 4) = (f32x4){bflo(unext.z), bfhi(unext.z), bflo(unext.w), bfhi(unext.w)}; }
        __syncthreads();
    }
}

__device__ __forceinline__ void post_tokens(KP p, int L, LAS unsigned char* lds) {
    const int tid = threadIdx.x, wid = tid >> 6, lane = tid & 63;
    LAS float* A2 = (LAS float*)lds;
    LAS float* G2 = (LAS float*)(lds + 32768);
    LAS float* SC = (LAS float*)(lds + 98304) + wid * 192;
    for (int i = tid; i < 32 * 256; i += 512) A2[i] = p->in[I_RA2][L * 8192 + i];
    for (int i = tid; i < 64 * 256; i += 512) G2[i] = p->in[I_RG2][L * 16384 + i];
    __syncthreads();
    const bf16_t* U = (const bf16_t*)(p->ws + WS_ACT); const bf16_t* ym = (const bf16_t*)(p->ws + WS_YM); const bf16_t* yr = (const bf16_t*)(p->ws + WS_YR);
    bf16_t* Y = (bf16_t*)(p->ws + WS_Y);
    const int c8 = lane * 8, c4 = lane * 4, hh = lane >> 4;
    float nw[8];
#pragma unroll
    for (int i = 0; i < 8; ++i) nw[i] = p->in[I_MNW][L * 512 + c8 + i];
    float mur[4], muk[4], muv[4], mux[4], a0v[4], kav[4], rkv[4], gnw[4], gnb[4];
#pragma unroll
    for (int i = 0; i < 4; ++i) {
        mur[i] = p->in[I_RMU][L * 896 + c4 + i]; muk[i] = p->in[I_RMU][L * 896 + 256 + c4 + i]; muv[i] = p->in[I_RMU][L * 896 + 512 + c4 + i];
        mux[i] = (lane < 24) ? p->in[I_RMU][L * 896 + 800 + c4 + i] : 0.f;
        a0v[i] = p->in[I_RA0][L * 256 + c4 + i]; kav[i] = p->in[I_RKA][L * 256 + c4 + i]; rkv[i] = p->in[I_RRK][L * 256 + c4 + i];
        gnw[i] = p->in[I_RGNW][L * 256 + c4 + i]; gnb[i] = p->in[I_RGNB][L * 256 + c4 + i];
    }
    struct PL { u32x4 yw, zw; u32x2 cr, ck, cv, cx, pr, pk, pv, px, yrw; };
    auto post_load = [&](int t) -> PL {
        PL q; const bf16_t* ut = U + (size_t)t * DINP; const bf16_t* ur = ut + UR0;
        q.yw = *(const u32x4*)(ym + (size_t)t * 512 + c8); q.zw = *(const u32x4*)(ut + Z0 + c8);
        q.cr = *(const u32x2*)(ur + c4); q.ck = *(const u32x2*)(ur + 256 + c4); q.cv = *(const u32x2*)(ur + 512 + c4); q.cx = (u32x2){0u, 0u};
        if (lane < 24) q.cx = *(const u32x2*)(ur + 800 + c4);
        q.pr = (u32x2){0u, 0u}; q.pk = q.pr; q.pv = q.pr; q.px = q.pr;
        if ((t & (SEQ - 1)) != 0) { q.pr = *(const u32x2*)(ur - DINP + c4); q.pk = *(const u32x2*)(ur - DINP + 256 + c4); q.pv = *(const u32x2*)(ur - DINP + 512 + c4); if (lane < 24) q.px = *(const u32x2*)(ur - DINP + 800 + c4); }
        q.yrw = *(const u32x2*)(yr + (size_t)t * 256 + c4);
        return q;
    };
    const int tstride = gridDim.x * 8;
    for (int t0 = blockIdx.x * 8 + wid; t0 < T; t0 += 2 * tstride) {
        const int t1 = t0 + tstride; const bool two = t1 < T;
        PL cu2[2]; cu2[0] = post_load(t0); cu2[1] = post_load(two ? t1 : t0);
        float xr[2][4], xk[2][4], xv[2][4];
#pragma unroll
        for (int u = 0; u < 2; ++u) {
            const PL& cu = cu2[u]; const int t = u ? t1 : t0;
            {
                const u32x4 yw = cu.yw;
                const f32x4 y0 = (f32x4){bflo(yw.x), bfhi(yw.x), bflo(yw.y), bfhi(yw.y)}, y1 = (f32x4){bflo(yw.z), bfhi(yw.z), bflo(yw.w), bfhi(yw.w)};
                const u32x4 zw = cu.zw;
                float v[8];
                v[0] = y0[0] * siluf_(bflo(zw.x)); v[1] = y0[1] * siluf_(bfhi(zw.x)); v[2] = y0[2] * siluf_(bflo(zw.y)); v[3] = y0[3] * siluf_(bfhi(zw.y));
                v[4] = y1[0] * siluf_(bflo(zw.z)); v[5] = y1[1] * siluf_(bfhi(zw.z)); v[6] = y1[2] * siluf_(bflo(zw.w)); v[7] = y1[3] * siluf_(bfhi(zw.w));
                float sq = 0.f;
#pragma unroll
                for (int i = 0; i < 8; ++i) sq += v[i] * v[i];
                sq = wave_sum64_dpp(sq);
                const float rs = rsqrtf(sq * (1.0f / 512.0f) + EPS);
                u32x4 w; w.x = cvt_pk_bf16(v[0] * rs * nw[0], v[1] * rs * nw[1]); w.y = cvt_pk_bf16(v[2] * rs * nw[2], v[3] * rs * nw[3]);
                w.z = cvt_pk_bf16(v[4] * rs * nw[4], v[5] * rs * nw[5]); w.w = cvt_pk_bf16(v[6] * rs * nw[6], v[7] * rs * nw[7]);
                if (u == 0 || two) *(u32x4*)(Y + (size_t)t * D + c8) = w;
            }
            {
                const u32x2 cr = cu.cr, ck = cu.ck, cv = cu.cv, cx = cu.cx, pr = cu.pr, pk = cu.pk, pv = cu.pv, px = cu.px;
                float xx[4];
                {
                    const float c_[4] = {bflo(cr.x), bfhi(cr.x), bflo(cr.y), bfhi(cr.y)}, p_[4] = {bflo(pr.x), bfhi(pr.x), bflo(pr.y), bfhi(pr.y)};
#pragma unroll
                    for (int i = 0; i < 4; ++i) xr[u][i] = c_[i] + (p_[i] - c_[i]) * mur[i];
                }
                {
                    const float c_[4] = {bflo(ck.x), bfhi(ck.x), bflo(ck.y), bfhi(ck.y)}, p_[4] = {bflo(pk.x), bfhi(pk.x), bflo(pk.y), bfhi(pk.y)};
#pragma unroll
                    for (int i = 0; i < 4; ++i) xk[u][i] = c_[i] + (p_[i] - c_[i]) * muk[i];
                }
                {
                    const float c_[4] = {bflo(cv.x), bfhi(cv.x), bflo(cv.y), bfhi(cv.y)}, p_[4] = {bflo(pv.x), bfhi(pv.x), bflo(pv.y), bfhi(pv.y)};
#pragma unroll
                    for (int i = 0; i < 4; ++i) xv[u][i] = c_[i] + (p_[i] - c_[i]) * muv[i];
                }
                {
                    const float c_[4] = {bflo(cx.x), bfhi(cx.x), bflo(cx.y), bfhi(cx.y)}, p_[4] = {bflo(px.x), bfhi(px.x), bflo(px.y), bfhi(px.y)};
#pragma unroll
                    for (int i = 0; i < 4; ++i) xx[i] = c_[i] + (p_[i] - c_[i]) * mux[i];
                }
                if (lane < 8) { *(LAS f32x4*)(SC + u * 96 + c4) = (f32x4){xx[0], xx[1], xx[2], xx[3]}; }
                else if (lane < 24) { *(LAS f32x4*)(SC + u * 96 + c4) = (f32x4){sigmoidf_(xx[0]), sigmoidf_(xx[1]), sigmoidf_(xx[2]), sigmoidf_(xx[3])}; }
            }
        }
        f32x4 aa0 = (f32x4){a0v[0], a0v[1], a0v[2], a0v[3]}, aa1 = aa0, gg0 = (f32x4){0.f, 0.f, 0.f, 0.f}, gg1 = gg0;
#pragma unroll 8
        for (int j = 0; j < 32; ++j) { const float s0 = SC[j], s1 = SC[96 + j]; const f32x4 w = *(const LAS f32x4*)(A2 + j * 256 + c4); aa0 += w * s0; aa1 += w * s1; }
#pragma unroll 8
        for (int j = 0; j < 64; ++j) { const float s0 = SC[32 + j], s1 = SC[128 + j]; const f32x4 w = *(const LAS f32x4*)(G2 + j * 256 + c4); gg0 += w * s0; gg1 += w * s1; }
#pragma unroll
        for (int u = 0; u < 2; ++u) {
            const f32x4 aa = u ? aa1 : aa0, gg = u ? gg1 : gg0; const int t = u ? t1 : t0;
            float bon = 0.f;
#pragma unroll
            for (int i = 0; i < 4; ++i) { const float a = sigmoidf_(aa[i]); const float kp = xk[u][i] * (1.0f + (a - 1.0f) * kav[i]); bon += xr[u][i] * kp * rkv[i]; }
            bon = dpp_row_sum16(bon);
            const u32x2 yrw = cu2[u].yrw; const f32x4 yv = (f32x4){bflo(yrw.x), bfhi(yrw.x), bflo(yrw.y), bfhi(yrw.y)};
            float mean = (yv[0] + yv[1]) + (yv[2] + yv[3]); mean = dpp_row_sum16(mean) * (1.0f / 64.0f);
            const float d0 = yv[0] - mean, d1 = yv[1] - mean, d2 = yv[2] - mean, d3 = yv[3] - mean;
            float var = (d0 * d0 + d1 * d1) + (d2 * d2 + d3 * d3); var = dpp_row_sum16(var) * (1.0f / 64.0f);
            const float rstd = rsqrtf(var + 64e-5f);
            const float o0 = (d0 * rstd * gnw[0] + gnb[0] + bon * xv[u][0]) * gg[0], o1 = (d1 * rstd * gnw[1] + gnb[1] + bon * xv[u][1]) * gg[1];
            const float o2 = (d2 * rstd * gnw[2] + gnb[2] + bon * xv[u][2]) * gg[2], o3 = (d3 * rstd * gnw[3] + gnb[3] + bon * xv[u][3]) * gg[3];
            u32x2 w; w.x = cvt_pk_bf16(o0, o1); w.y = cvt_pk_bf16(o2, o3);
            if (u == 0 || two) *(u32x2*)(Y + (size_t)t * D + 768 + c4) = w;
        }
    }
}

#define XB_TMO      128
#define XB_XCNT(j)  (256  + 64 * (j))
#define XB_XSUB(j)  (1280 + 64 * (j))
#define XB_XGEN(j)  (2304 + 64 * (j))
#define XB_TOP      3328
#define XB_TOPGEN   3392
#define XCD_BAR_WORDS 3456
#define XB_SPIN_CAP (1u << 22)
__device__ __forceinline__ unsigned xb_ld(unsigned* p)              { return __hip_atomic_load(p, __ATOMIC_RELAXED, __HIP_MEMORY_SCOPE_AGENT); }
__device__ __forceinline__ unsigned xb_add(unsigned* p, unsigned v) { return __hip_atomic_fetch_add(p, v, __ATOMIC_RELAXED, __HIP_MEMORY_SCOPE_AGENT); }
__device__ __forceinline__ unsigned xb_xcc_id() { return (unsigned)__builtin_amdgcn_s_getreg((3 << 11) | 20) & 0xFu; }
#define XB_SPIN(cond, bar) do { unsigned _sp = 0; while (cond) { __builtin_amdgcn_s_sleep(1); \
    if ((++_sp & 255u) == 0u) { if (xb_ld(&(bar)[XB_TMO])) break; if (_sp > XB_SPIN_CAP) { atomicAdd(&(bar)[XB_TMO], 1u); break; } } } } while (0)
struct XcdBarrier { unsigned* bar; unsigned x; volatile LAS unsigned* st; };
__device__ __forceinline__ XcdBarrier xcd_barrier_post(unsigned* bar, volatile LAS unsigned* st) {
    XcdBarrier b; b.bar = bar; b.x = xb_xcc_id(); b.st = st;
    if (threadIdx.x == 0) (void)xb_add(&bar[XB_XCNT(b.x)], 1u);
    return b;
}
__device__ __forceinline__ void xcd_barrier_complete(unsigned* bar, unsigned x, unsigned& nloc, unsigned& nx) {
    const unsigned G = gridDim.x * gridDim.y * gridDim.z;
    unsigned sum, cnt, mine, sp = 0u;
    for (;;) {
        sum = 0u; cnt = 0u; mine = 0u;
#pragma unroll
        for (unsigned j = 0; j < 16; ++j) { const unsigned c = xb_ld(&bar[XB_XCNT(j)]); sum += c; cnt += (c > 0u) ? 1u : 0u; mine = (j == x) ? c : mine; }
        if (sum == G) break;
        __builtin_amdgcn_s_sleep(1);
        if ((++sp & 255u) == 0u) { if (xb_ld(&bar[XB_TMO])) break; if (sp > XB_SPIN_CAP) { atomicAdd(&bar[XB_TMO], 1u); break; } }
    }
    nloc = mine > 0u ? mine : 1u; nx = cnt > 0u ? cnt : 1u;
}
__device__ __forceinline__ void xcd_barrier(const XcdBarrier& b) {
    asm volatile("s_waitcnt vmcnt(0)" ::: "memory");
    __syncthreads();
    if (threadIdx.x == 0) {
        unsigned* bar = b.bar;
        __builtin_amdgcn_s_waitcnt(0);
        unsigned nloc = b.st[0], nx = b.st[1];
        if (nloc == 0u) { xcd_barrier_complete(bar, b.x, nloc, nx); b.st[0] = nloc; b.st[1] = nx; }
        const unsigned old = xb_add(&bar[XB_XSUB(b.x)], 1u);
        const unsigned gen = old / nloc;
        if (old + 1u == (gen + 1u) * nloc) {
            __builtin_amdgcn_fence(__ATOMIC_RELEASE, "agent");
            asm volatile("s_waitcnt vmcnt(0)" ::: "memory");
            const unsigned og = xb_add(&bar[XB_TOP], 1u);
            const unsigned tg = og / nx;
            if (og + 1u == (tg + 1u) * nx) xb_add(&bar[XB_TOPGEN], 1u);
            else XB_SPIN(xb_ld(&bar[XB_TOPGEN]) == tg, bar);
            __builtin_amdgcn_fence(__ATOMIC_ACQUIRE, "agent");
            xb_add(&bar[XB_XGEN(b.x)], 1u);
            asm volatile("s_waitcnt vmcnt(0)" ::: "memory");
        } else {
            XB_SPIN(xb_ld(&bar[XB_XGEN(b.x)]) == gen, bar);
            __builtin_amdgcn_fence(__ATOMIC_ACQUIRE, "agent");
            asm volatile("s_waitcnt vmcnt(0)" ::: "memory");
        }
    }
    __syncthreads();
}

constexpr int PH_PER_LAYER = 9, N_PHASES = 2 + 2 * PH_PER_LAYER;
#ifndef PROBE_ID
#define PROBE_ID 0
#endif
#define REPS(id) ((PROBE_ID == (id)) ? 2 : 1)
#define IN_PH(k) (p->ph_lo <= (k) && (k) < p->ph_hi)
#define SEAM(k) do { if (IN_PH(k) && IN_PH((k) + 1)) xcd_barrier(bar); } while (0)
template <int L>
__device__ __forceinline__ void layer_phases(LAS unsigned char* lds, const XcdBarrier& bar) {
    const int G = gridDim.x, blk = blockIdx.x;
    constexpr int P0 = 1 + PH_PER_LAYER * L;
    KP p = fresh_kp();
    bf16_t* W = (bf16_t*)(p->ws + WS_W);
    const bf16_t* WL = W + (size_t)L * LW;
    bf16_t* XB = (bf16_t*)(p->ws + WS_XB); bf16_t* Y = (bf16_t*)(p->ws + WS_Y); bf16_t* ACT = (bf16_t*)(p->ws + WS_ACT);
    float* DTB = (float*)(p->ws + WS_DT); float* SSQ = (float*)(p->ws + WS_SSQ); bf16_t* YS = (bf16_t*)(p->ws + WS_YS);
    float* const SQa = SSQ + (size_t)(L & 1) * T; float* const SQb = SSQ + (size_t)((L + 1) & 1) * T;
#define ZERO_ROWS(buf) do { for (int r_ = blk * 512 + (int)threadIdx.x; r_ < T; r_ += G * 512) (buf)[r_] = 0.f; } while (0)
    if (IN_PH(P0 + 0)) {
        pg8::StaticOrder S; pg8::Gemm g{XB, WL + LW_GU1, T, 5632, D}; S.init(T, 5632, G, blk);
        EpiSwiglu E{ACT, SQa}; for (int rep = 0; rep < REPS(2); ++rep) pg8::gemm_phase<true>(lds, g, S, E);
    }
    SEAM(P0 + 0);
    if (IN_PH(P0 + 1)) {
        pg8::StaticOrder S; pg8::Gemm g{ACT, WL + LW_D1, T, D, FF}; S.init(T, D, G, blk);
        ZERO_ROWS(SQa);
        EpiResid E{XB, SQb, 0.5f}; pg8::gemm_phase(lds, g, S, E);
    }
    SEAM(P0 + 1);
    if (IN_PH(P0 + 2)) {
        pg8::StaticOrder S; pg8::Gemm g{XB, WL + LW_IN, T, DINP, D}; S.init(T, DINP, G, blk);
        EpiU E{ACT, DTB, SQb}; for (int rep = 0; rep < REPS(4); ++rep) pg8::gemm_phase<true>(lds, g, S, E);
    }
    SEAM(P0 + 2);
    if (IN_PH(P0 + 3)) {
        rwkv_prep_phase(p, L, lds); __syncthreads();
        ssd_bc_prepass(p, L);
        if (PROBE_ID == 5) { rwkv_prep_phase(fresh_kp(), L, lds); __syncthreads(); }
        for (int rep = 0; rep < REPS(6); ++rep)
        if (G != 256) for (int u = blk; u < 256; u += G) ssd_passA(p, L, lds, u);
        for (int rep = 0; rep < REPS(7); ++rep)
        for (int u = blk; u < 256; u += G) s5_unit(p, L, lds, u);
    }
    SEAM(P0 + 3);
    if (IN_PH(P0 + 4)) {
        if (G == 256) {
            const int xcd = blk & 7, slot = (blk >> 3) & 15;
            if (blk < 128) rwkv_unit(p, L, lds, ((xcd * 8 + (slot >> 1)) << 1) | (slot & 1));
            if (blk >= 128) { const int gi = xcd * 4 + (slot >> 2), bb_ = gi >> 1, hd_ = (gi & 1) * 4 + (slot & 3); ssd_passB(p, L, lds, 2 * (bb_ * 8 + hd_), true); }
        } else {
            for (int u = blk; u < 128; u += G) rwkv_unit(p, L, lds, u);
            for (int u = blk; u < 256; u += G) ssd_passB(p, L, lds, u, false);
        }
    }
    SEAM(P0 + 4);
    if (IN_PH(P0 + 5)) {
        pg8::StaticOrder S; pg8::Gemm g{YS, WL + LW_GLU, T, 256, 256}; S.init(T, 256, G, blk);
        EpiGlu E{YS, p->in[I_SGB] + L * 256, Y};
        pg8::gemm_phase(lds, g, S, E); __syncthreads(); post_tokens(p, L, lds); __syncthreads();
        if (PROBE_ID == 10) { post_tokens(fresh_kp(), L, lds); __syncthreads(); }
    }
    SEAM(P0 + 5);
    if (IN_PH(P0 + 6)) {
        pg8::StaticOrder S; pg8::Gemm g{Y, WL + LW_OUT, T, D, D}; S.init(T, D, G, blk);
        ZERO_ROWS(SQb);
        EpiResid E{XB, SQa, 1.0f}; pg8::gemm_phase(lds, g, S, E);
    }
    SEAM(P0 + 6);
    if (IN_PH(P0 + 7)) {
        pg8::StaticOrder S; pg8::Gemm g{XB, WL + LW_GU2, T, 5632, D}; S.init(T, 5632, G, blk);
        EpiSwiglu E{ACT, SQa}; pg8::gemm_phase<true>(lds, g, S, E);
    }
    SEAM(P0 + 7);
    if (IN_PH(P0 + 8)) {
        pg8::StaticOrder S; pg8::Gemm g{ACT, WL + LW_D2, T, D, FF}; S.init(T, D, G, blk);
        ZERO_ROWS(SQa);
        EpiResid E{XB, SQb, 0.5f}; pg8::gemm_phase(lds, g, S, E);
    }
    SEAM(P0 + 8);
}
__global__ void __launch_bounds__(512, 2) fwd_megakernel(Params p_unused) {
    extern __shared__ __attribute__((aligned(16))) unsigned char lds_raw[];
    LAS unsigned char* lds = (LAS unsigned char*)lds_raw;
    cg::grid_group grid = cg::this_grid();
    KP p = fresh_kp();
    volatile LAS unsigned* bst = (volatile LAS unsigned*)(lds + LDS_BYTES - 64);
    if (threadIdx.x == 0) { bst[0] = 0u; bst[1] = 0u; }
    unsigned* barw = (unsigned*)(p->ws + WS_BAR);
    if (blockIdx.x == 0) for (int i = threadIdx.x; i < XCD_BAR_WORDS; i += 512) barw[i] = 0u;
    prologue(fresh_kp(), lds);
    grid.sync();
    const XcdBarrier bar = xcd_barrier_post(barw, bst);
    if (PROBE_ID == 11) { for (int i = 0; i < 20; ++i) xcd_barrier(bar); }
    layer_phases<0>(lds, bar);
    layer_phases<1>(lds, bar);
    final_norm(fresh_kp());
}

extern "C" void kernel_launch(void* const* d_in, const int* in_sizes, int n_in, void* d_out, int out_size, void* d_ws, size_t ws_size, hipStream_t stream) {
    static int grid_blocks = 0;
    if (grid_blocks == 0) {
        if (n_in != N_IN || out_size != T * D || ws_size < WS_END) { fprintf(stderr, "kernel_launch: unexpected shapes (n_in %d, out %d, ws %zu, need %zu)\n", n_in, out_size, ws_size, (size_t)WS_END); grid_blocks = -1; return; }
        int dev = 0, cus = 0, per_cu = 0;
        hipGetDevice(&dev);
        hipDeviceGetAttribute(&cus, hipDeviceAttributeMultiprocessorCount, dev);
        hipFuncSetAttribute((const void*)fwd_megakernel, hipFuncAttributeMaxDynamicSharedMemorySize, LDS_BYTES);
        hipOccupancyMaxActiveBlocksPerMultiprocessor(&per_cu, (const void*)fwd_megakernel, 512, LDS_BYTES);
        if (per_cu < 1) { fprintf(stderr, "kernel_launch: occupancy query says %d blocks per CU\n", per_cu); per_cu = 1; }
        grid_blocks = cus * per_cu;
        (void)hipGetLastError();
    }
    if (grid_blocks < 0) return;
    Params p{};
    for (int i = 0; i < N_IN; ++i) p.in[i] = (const float*)d_in[i];
    p.out = (float*)d_out; p.ws = (unsigned char*)d_ws; p.ph_lo = 0; p.ph_hi = N_PHASES;
    void* args[] = {&p};
    hipError_t e = hipLaunchCooperativeKernel((const void*)fwd_megakernel, dim3(grid_blocks), dim3(512), args, LDS_BYTES, stream);
    if (e != hipSuccess) fprintf(stderr, "cooperative launch failed: %s (grid %d)\n", hipGetErrorString(e), grid_blocks);
}
```

```cpp
#include <hip/hip_runtime.h>
#include <hip/hip_cooperative_groups.h>
#include <cstdio>
#include <cstdint>
namespace cg = cooperative_groups;

#define LAS __attribute__((address_space(3)))
typedef unsigned short bf16_t;
typedef short bf16x8 __attribute__((ext_vector_type(8)));
typedef float f32x4 __attribute__((ext_vector_type(4)));
typedef float f32x2 __attribute__((ext_vector_type(2)));
typedef unsigned u32x4 __attribute__((ext_vector_type(4)));
typedef unsigned u32x2 __attribute__((ext_vector_type(2)));

__device__ __forceinline__ unsigned cvt_pk_bf16(float lo, float hi) { unsigned r; asm("v_cvt_pk_bf16_f32 %0, %1, %2" : "=v"(r) : "v"(lo), "v"(hi)); return r; }
__device__ __forceinline__ bf16_t f2bf(float f) { return (bf16_t)(cvt_pk_bf16(f, 0.f) & 0xffffu); }
__device__ __forceinline__ float bf2f(unsigned b) { return __uint_as_float(b << 16); }
__device__ __forceinline__ float bflo(unsigned w) { return __uint_as_float(w << 16); }
__device__ __forceinline__ float bfhi(unsigned w) { return __uint_as_float(w & 0xffff0000u); }
typedef _Float16 f16x8 __attribute__((ext_vector_type(8)));
typedef _Float16 f16x2 __attribute__((ext_vector_type(2)));
__device__ __forceinline__ unsigned cvt_pk_f16(float lo, float hi) { union { f16x2 h; unsigned u; } c; c.h[0] = (_Float16)lo; c.h[1] = (_Float16)hi; return c.u; }
__device__ __forceinline__ float f16lo(unsigned w) { union { f16x2 h; unsigned u; } c; c.u = w; return (float)c.h[0]; }
__device__ __forceinline__ float f16hi(unsigned w) { union { f16x2 h; unsigned u; } c; c.u = w; return (float)c.h[1]; }
__device__ __forceinline__ float sigmoidf_(float x) { return __builtin_amdgcn_rcpf(1.0f + __expf(-x)); }
__device__ __forceinline__ float siluf_(float x) { return x * sigmoidf_(x); }
__device__ __forceinline__ float tanhf_(float x) { return 1.0f - 2.0f * __builtin_amdgcn_rcpf(1.0f + __expf(2.0f * x)); }
__device__ __forceinline__ float softplusf_(float x) { return x > 20.f ? x : __logf(1.0f + __expf(x)); }
__device__ __forceinline__ float wave_sum64(float v) {
    v += __shfl_xor(v, 32); v += __shfl_xor(v, 16); v += __shfl_xor(v, 8); v += __shfl_xor(v, 4); v += __shfl_xor(v, 2); v += __shfl_xor(v, 1); return v;
}
__device__ __forceinline__ float dpp_row_sum16(float v) {
    int x;
    x = __builtin_amdgcn_update_dpp(0, __float_as_int(v), 0xB1, 0xF, 0xF, true); v += __int_as_float(x);
    x = __builtin_amdgcn_update_dpp(0, __float_as_int(v), 0x4E, 0xF, 0xF, true); v += __int_as_float(x);
    x = __builtin_amdgcn_update_dpp(0, __float_as_int(v), 0x141, 0xF, 0xF, true); v += __int_as_float(x);
    x = __builtin_amdgcn_update_dpp(0, __float_as_int(v), 0x140, 0xF, 0xF, true); v += __int_as_float(x);
    return v;
}

__device__ __forceinline__ float wave_sum64_dpp(float v) {
    v = dpp_row_sum16(v);
    const int iv = __float_as_int(v);
    return (__int_as_float(__builtin_amdgcn_readlane(iv, 0)) + __int_as_float(__builtin_amdgcn_readlane(iv, 16))) + (__int_as_float(__builtin_amdgcn_readlane(iv, 32)) + __int_as_float(__builtin_amdgcn_readlane(iv, 48)));
}
constexpr int T = 32768, SEQ = 2048, D = 1024, FF = 2816, DINP = 2816;
constexpr int Z0 = 0, XBC0 = 512, DT0 = 1536, US0 = 1544, UR0 = 1800;
constexpr float EPS = 1e-5f;
enum { I_X = 0, I_F1N, I_F1G, I_F1U, I_F1D, I_MN, I_WIN, I_WOUT, I_MALOG, I_MDTB, I_MCW, I_MCB, I_MD, I_MNW,
       I_SARE, I_SAIM, I_SBRE, I_SBIM, I_SCRE, I_SCIM, I_SLDT, I_SD, I_SGW, I_SGB,
       I_RMU, I_RW0, I_RW2, I_RA0, I_RA2, I_RG2, I_RKK, I_RKA, I_RRK, I_RGNW, I_RGNB,
       I_F2N, I_F2G, I_F2U, I_F2D, I_FN, N_IN };

constexpr size_t WB_GU = (size_t)5632 * 1024, WB_D = (size_t)1024 * 2816, WB_IN = (size_t)2816 * 1024, WB_OUT = (size_t)1024 * 1024, WB_GLU = 256 * 256;
constexpr size_t LW_GU1 = 0, LW_D1 = LW_GU1 + WB_GU, LW_IN = LW_D1 + WB_D, LW_OUT = LW_IN + WB_IN, LW_GU2 = LW_OUT + WB_OUT, LW_D2 = LW_GU2 + WB_GU, LW_GLU = LW_D2 + WB_D, LW = LW_GLU + WB_GLU;
constexpr size_t WS_W = 0;
constexpr size_t WS_XB = WS_W + 2 * LW * 2;
constexpr size_t WS_Y = WS_XB + (size_t)T * 1024 * 2;
constexpr size_t WS_ACT = WS_Y + (size_t)T * 1024 * 2;
constexpr size_t WS_DT = WS_ACT + (size_t)T * 2816 * 2;
constexpr size_t WS_SSQ = WS_DT + (size_t)T * 8 * 4;
constexpr size_t WS_YM = WS_SSQ + (size_t)T * 16 * 4;
constexpr size_t WS_YS = WS_YM + (size_t)T * 512 * 2;
constexpr size_t WS_YR = WS_YS + (size_t)T * 256 * 2;
constexpr size_t WS_SL = WS_YR + (size_t)T * 256 * 2;
constexpr size_t WS_DEC = WS_SL + (size_t)16 * 8 * 8 * 8192 * 2;
constexpr size_t WS_BAR = WS_DEC + 16 * 8 * 8 * 4;
constexpr size_t WS_BCC = WS_BAR + 4096 * 4;
constexpr size_t WS_END = WS_BCC + (size_t)T * 512 * 2;
static_assert(WS_END <= (size_t)536870912, "workspace");
constexpr int LDS_BYTES = 152 * 1024;

struct Params { const float* in[N_IN]; float* out; unsigned char* ws; int ph_lo, ph_hi; };
typedef const __attribute__((address_space(4))) Params* KP;
__device__ __forceinline__ KP fresh_kp() { KP k = (KP)__builtin_amdgcn_kernarg_segment_ptr(); asm volatile("" : "+s"(k)); return k; }

namespace pg8 {
constexpr int BM = 256, BK = 64, HALF = 128, HTB = HALF * BK * 2, STAGE_BYTES = 8 * HTB, NXCD = 8, WGM = 8;
__host__ __device__ __forceinline__ int lds_byte(int r, int c) { const int st = (r >> 4) * 2 + (c >> 5), rr = r & 15, cc = c & 31, ob = rr * 64 + cc * 2; return st * 1024 + (ob ^ (((ob >> 9) & 1) << 5)); }
__host__ __device__ __forceinline__ void stage_rc(int b, int& R, int& C) { const int st = b / 1024, sb = b % 1024, swz = sb ^ (((sb >> 9) & 1) << 5); R = (st >> 1) * 16 + swz / 64; C = (st & 1) * 32 + (swz % 64) / 2; }
__host__ __device__ __forceinline__ int perm32(int rho) { const int n = rho >> 4, i = rho & 15; return 8 * (i >> 2) + 4 * n + (i & 3); }
struct Unit { int pm, pn; };
struct Gemm { const bf16_t* A; const bf16_t* Bt; int M, N, K; };
struct StaticOrder {
    int nM, nN, nwg, G, c;
    __host__ __device__ void init(int M, int N, int G_, int c_) { nM = M / BM; nN = N / BM; nwg = nM * nN; G = G_; c = c_; }
    __host__ __device__ bool next(int i, Unit& u) const {
        const long L = (long)i * G + c; if (L >= nwg) return false;
        int wgid = (int)L; { const int q = nwg / NXCD, r = nwg % NXCD, xcd = wgid % NXCD, off = wgid / NXCD; wgid = (xcd < r ? xcd * (q + 1) : r * (q + 1) + (xcd - r) * q) + off; }
        const int nig = WGM * nN, gid = wgid / nig, fm = gid * WGM, gsz = (nM - fm) < WGM ? (nM - fm) : WGM;
        u.pm = fm + ((wgid % nig) % gsz); u.pn = (wgid % nig) / gsz; return true;
    }
};
template <bool F16 = false, class Epi>
__device__ __forceinline__ void gemm_phase(LAS unsigned char* lds, const Gemm g, const StaticOrder& S, const Epi& E) {
    const int tid = threadIdx.x, wid = __builtin_amdgcn_readfirstlane(tid >> 6), lane = tid & 63, wr = wid >> 2, wc = wid & 3, fr = lane & 15, fq = lane >> 4;
    const int K = g.K, nt = K / BK;
    unsigned voffA[2], voffB[2];
#pragma unroll
    for (int i = 0; i < 2; ++i) { int R, C; stage_rc(tid * 16 + i * 8192, R, C); const int Rb = Epi::PERM ? ((R & ~31) + perm32(R & 31)) : R;
        voffA[i] = (unsigned)(R * K + C) * 2u; voffB[i] = (unsigned)(Rb * K + C) * 2u; }
    const size_t kstep = (size_t)(BK * 2);
    const size_t hstep = (size_t)HALF * K * 2;
    const size_t tstep = 2 * hstep;
    const unsigned ldsw = (unsigned)wid * 1024u;
    const int aoff = lds_byte(wr * 64 + fr, fq * 8), boff = lds_byte(wc * 32 + fr, fq * 8);
#define PG8_SA(b, h) (((b) * 2 + (h)) * HTB)
#define PG8_SB(b, h) ((4 + (b) * 2 + (h)) * HTB)
#define PG8_STAGE(bufoff, gbase, voff) do { _Pragma("unroll") for (int _i = 0; _i < 2; ++_i) \
        __builtin_amdgcn_global_load_lds((const unsigned*)((const char*)(gbase) + (voff)[_i]), (LAS unsigned*)(lds + (bufoff) + ldsw + _i * 8192), 16, 0, 0); } while (0)
#define PG8_LDA(dst, b, h) do { _Pragma("unroll") for (int m = 0; m < 4; ++m) _Pragma("unroll") for (int k = 0; k < 2; ++k) dst[m][k] = *(const LAS bf16x8*)(lds + PG8_SA(b, h) + aoff + m * 2048 + k * 1024); } while (0)
#define PG8_LDB(dst, b, h) do { _Pragma("unroll") for (int n = 0; n < 2; ++n) _Pragma("unroll") for (int k = 0; k < 2; ++k) dst[n][k] = *(const LAS bf16x8*)(lds + PG8_SB(b, h) + boff + n * 2048 + k * 1024); } while (0)
#define PG8_MMA(ai, bj, At, Bt) do { __builtin_amdgcn_s_setprio(1); _Pragma("unroll") for (int m = 0; m < 4; ++m) _Pragma("unroll") for (int n = 0; n < 2; ++n) _Pragma("unroll") for (int k = 0; k < 2; ++k) \
        acc[ai][bj][m][n] = F16 ? __builtin_amdgcn_mfma_f32_16x16x32_f16(__builtin_bit_cast(f16x8, Bt[n][k]), __builtin_bit_cast(f16x8, At[m][k]), acc[ai][bj][m][n], 0, 0, 0) \
                                : __builtin_amdgcn_mfma_f32_16x16x32_bf16(Bt[n][k], At[m][k], acc[ai][bj][m][n], 0, 0, 0); __builtin_amdgcn_s_setprio(0); } while (0)
#define PG8_WAIT_V(n) asm volatile("s_waitcnt vmcnt(" #n ")" ::: "memory")
#define PG8_WAIT_L(n) asm volatile("s_waitcnt lgkmcnt(" #n ")" ::: "memory")
#define PG8_BAR __builtin_amdgcn_s_barrier()
#define PG8_SCHED __builtin_amdgcn_sched_barrier(0)
    Unit cur, nxt; int ui = 0;
    if (!S.next(0, cur)) return;
    f32x4 acc[2][2][4][2];
#pragma unroll
    for (int a = 0; a < 2; ++a)
#pragma unroll
        for (int b = 0; b < 2; ++b)
#pragma unroll
            for (int m = 0; m < 4; ++m)
#pragma unroll
                for (int n = 0; n < 2; ++n) acc[a][b][m][n] = (f32x4){0.f, 0.f, 0.f, 0.f};
    bf16x8 At[4][2], B0[2][2], B1[2][2];
    const char* cA = (const char*)g.A + (size_t)cur.pm * tstep; const char* cB = (const char*)g.Bt + (size_t)cur.pn * tstep;
    PG8_STAGE(PG8_SB(0, 0), cB, voffB); PG8_STAGE(PG8_SB(0, 1), cB + hstep, voffB); PG8_STAGE(PG8_SA(0, 0), cA, voffA); PG8_STAGE(PG8_SA(0, 1), cA + hstep, voffA);
    if (wr == 1) PG8_BAR;
    PG8_WAIT_V(2); PG8_BAR;
    PG8_STAGE(PG8_SB(1, 0), cB + kstep, voffB); PG8_STAGE(PG8_SA(1, 0), cA + kstep, voffA); PG8_STAGE(PG8_SB(1, 1), cB + hstep + kstep, voffB);
    PG8_WAIT_V(6); PG8_BAR;
    for (;;) {
        const bool has_next = S.next(ui + 1, nxt);
        const char* nA = has_next ? (const char*)g.A + (size_t)nxt.pm * tstep : cA; const char* nB = has_next ? (const char*)g.Bt + (size_t)nxt.pn * tstep : cB;
        for (int t = 0; t < nt; t += 2) {
            const bool last = (t == nt - 2);
            const char* a1 = cA + (size_t)(t + 1) * kstep;
            const char* a2 = last ? nA : cA + (size_t)(t + 2) * kstep; const char* b2 = last ? nB : cB + (size_t)(t + 2) * kstep;
            const char* a3 = a2 + kstep; const char* b3 = b2 + kstep;
            PG8_LDB(B0, 0, 0); PG8_LDB(B1, 0, 1); PG8_SCHED; PG8_LDA(At, 0, 0); PG8_STAGE(PG8_SA(1, 1), a1 + hstep, voffA);
            PG8_WAIT_V(8); PG8_WAIT_L(0); PG8_BAR; PG8_MMA(0, 0, At, B0); PG8_MMA(0, 1, At, B1); PG8_BAR; PG8_SCHED;
            PG8_LDA(At, 0, 1); PG8_STAGE(PG8_SB(0, 0), b2, voffB); PG8_STAGE(PG8_SB(0, 1), b2 + hstep, voffB); PG8_STAGE(PG8_SA(0, 0), a2, voffA);
            PG8_WAIT_V(8); PG8_WAIT_L(0); PG8_BAR; PG8_MMA(1, 0, At, B0); PG8_MMA(1, 1, At, B1); PG8_BAR; PG8_SCHED;
            PG8_LDB(B0, 1, 0); PG8_LDB(B1, 1, 1); PG8_SCHED; PG8_LDA(At, 1, 0); PG8_STAGE(PG8_SA(0, 1), a2 + hstep, voffA);
            PG8_WAIT_V(8); PG8_WAIT_L(0); PG8_BAR; PG8_MMA(0, 0, At, B0); PG8_MMA(0, 1, At, B1); PG8_BAR; PG8_SCHED;
            PG8_LDA(At, 1, 1); PG8_STAGE(PG8_SB(1, 0), b3, voffB); PG8_STAGE(PG8_SB(1, 1), b3 + hstep, voffB); PG8_STAGE(PG8_SA(1, 0), a3, voffA);
            PG8_WAIT_V(8); PG8_WAIT_L(0); PG8_BAR; PG8_MMA(1, 0, At, B0); PG8_MMA(1, 1, At, B1); PG8_BAR; PG8_SCHED;
        }
        if (wr == 0) PG8_BAR;
        E(acc, cur, wr, wc, fr, fq);
        if (!has_next) break;
#pragma unroll
        for (int a = 0; a < 2; ++a)
#pragma unroll
            for (int b = 0; b < 2; ++b)
#pragma unroll
                for (int m = 0; m < 4; ++m)
#pragma unroll
                    for (int n = 0; n < 2; ++n) acc[a][b][m][n] = (f32x4){0.f, 0.f, 0.f, 0.f};
        cur = nxt; cA = nA; cB = nB; ++ui;
        if (wr == 1) PG8_BAR;
    }
    PG8_WAIT_V(0);
    PG8_BAR;
#undef PG8_SA
#undef PG8_SB
#undef PG8_STAGE
#undef PG8_LDA
#undef PG8_LDB
#undef PG8_MMA
#undef PG8_WAIT_V
#undef PG8_WAIT_L
#undef PG8_BAR
#undef PG8_SCHED
}
}

__device__ __forceinline__ float row_rstd(const float* ssq, int r) { return rsqrtf(ssq[r] * (1.0f / 1024.0f) + EPS); }
struct EpiSwiglu {
    static constexpr bool PERM = true;
    bf16_t* O; const float* ssq;
    __device__ __forceinline__ void operator()(const f32x4 (&acc)[2][2][4][2], const pg8::Unit& u, int wr, int wc, int fr, int fq) const {
        const int row0 = u.pm * 256 + wr * 64 + fr, col0 = u.pn * 128 + wc * 32 + 8 * fq;
        float sq[2][4];
#pragma unroll
        for (int ai = 0; ai < 2; ++ai)
#pragma unroll
            for (int m = 0; m < 4; ++m) sq[ai][m] = ssq[row0 + ai * 128 + m * 16];
#pragma unroll
        for (int ai = 0; ai < 2; ++ai)
#pragma unroll
            for (int m = 0; m < 4; ++m) {
                const int r = row0 + ai * 128 + m * 16; const float rs = rsqrtf(sq[ai][m] * (1.0f / 1024.0f) + EPS);
                float o[8];
#pragma unroll
                for (int n = 0; n < 2; ++n)
#pragma unroll
                    for (int j = 0; j < 4; ++j) { const float gv = acc[ai][0][m][n][j] * rs, uv = acc[ai][1][m][n][j] * rs; o[n * 4 + j] = siluf_(gv) * uv; }
                u32x4 w; w.x = cvt_pk_bf16(o[0], o[1]); w.y = cvt_pk_bf16(o[2], o[3]); w.z = cvt_pk_bf16(o[4], o[5]); w.w = cvt_pk_bf16(o[6], o[7]);
                *(u32x4*)(O + (size_t)r * FF + col0) = w;
            }
    }
};
struct EpiResid {
    static constexpr bool PERM = true;
    bf16_t* xb; float* ssq; float scale;
    __device__ __forceinline__ void operator()(const f32x4 (&acc)[2][2][4][2], const pg8::Unit& u, int wr, int wc, int fr, int fq) const {
        const int row0 = u.pm * 256 + wr * 64 + fr, col0 = u.pn * 256 + wc * 32 + 8 * fq;
#pragma unroll
        for (int ai = 0; ai < 2; ++ai)
#pragma unroll
            for (int m = 0; m < 4; ++m) {
                const int r = row0 + ai * 128 + m * 16; float s = 0.f;
#pragma unroll
                for (int bj = 0; bj < 2; ++bj) {
                    bf16_t* px = xb + (size_t)r * D + col0 + bj * 128;
                    const u32x4 xo = *(const u32x4*)px;
                    const f32x4 a0 = acc[ai][bj][m][0] * scale, a1 = acc[ai][bj][m][1] * scale;
                    float v[8];
                    v[0] = f16lo(xo.x) + a0[0]; v[1] = f16hi(xo.x) + a0[1]; v[2] = f16lo(xo.y) + a0[2]; v[3] = f16hi(xo.y) + a0[3];
                    v[4] = f16lo(xo.z) + a1[0]; v[5] = f16hi(xo.z) + a1[1]; v[6] = f16lo(xo.w) + a1[2]; v[7] = f16hi(xo.w) + a1[3];
                    u32x4 w; w.x = cvt_pk_f16(v[0], v[1]); w.y = cvt_pk_f16(v[2], v[3]); w.z = cvt_pk_f16(v[4], v[5]); w.w = cvt_pk_f16(v[6], v[7]);
                    *(u32x4*)px = w;
                    s += ((v[0] * v[0] + v[1] * v[1]) + (v[2] * v[2] + v[3] * v[3])) + ((v[4] * v[4] + v[5] * v[5]) + (v[6] * v[6] + v[7] * v[7]));
                }
                s += __shfl_xor(s, 16); s += __shfl_xor(s, 32);
                if (fq == 0) (void)__hip_atomic_fetch_add(ssq + r, s, __ATOMIC_RELAXED, __HIP_MEMORY_SCOPE_AGENT);
            }
    }
};
struct EpiU {
    static constexpr bool PERM = true;
    bf16_t* U; float* dt; const float* ssq;
    __device__ __forceinline__ void operator()(const f32x4 (&acc)[2][2][4][2], const pg8::Unit& u, int wr, int wc, int fr, int fq) const {
        const int row0 = u.pm * 256 + wr * 64 + fr, col0 = u.pn * 256 + wc * 32 + 8 * fq;
        float sq[2][4];
#pragma unroll
        for (int ai = 0; ai < 2; ++ai)
#pragma unroll
            for (int m = 0; m < 4; ++m) sq[ai][m] = ssq[row0 + ai * 128 + m * 16];
#pragma unroll
        for (int ai = 0; ai < 2; ++ai)
#pragma unroll
            for (int m = 0; m < 4; ++m) {
                const int r = row0 + ai * 128 + m * 16; const float rs = rsqrtf(sq[ai][m] * (1.0f / 1024.0f) + EPS);
#pragma unroll
                for (int bj = 0; bj < 2; ++bj) {
                    const int c = col0 + bj * 128; const f32x4 v0 = acc[ai][bj][m][0] * rs, v1 = acc[ai][bj][m][1] * rs;
                    u32x4 w; w.x = cvt_pk_bf16(v0[0], v0[1]); w.y = cvt_pk_bf16(v0[2], v0[3]); w.z = cvt_pk_bf16(v1[0], v1[1]); w.w = cvt_pk_bf16(v1[2], v1[3]);
                    *(u32x4*)(U + (size_t)r * DINP + c) = w;
                    if (c == DT0) { *(f32x4*)(dt + (size_t)r * 8) = v0; *(f32x4*)(dt + (size_t)r * 8 + 4) = v1; }
                }
            }
    }
};
struct EpiGlu {
    static constexpr bool PERM = true;
    const bf16_t* ys; const float* bias; bf16_t* Y;
    __device__ __forceinline__ void operator()(const f32x4 (&acc)[2][2][4][2], const pg8::Unit& u, int wr, int wc, int fr, int fq) const {
        const int row0 = u.pm * 256 + wr * 64 + fr, col0 = u.pn * 256 + wc * 32 + 8 * fq;
#pragma unroll
        for (int ai = 0; ai < 2; ++ai)
#pragma unroll
            for (int m = 0; m < 4; ++m) {
                const int r = row0 + ai * 128 + m * 16;
#pragma unroll
                for (int bj = 0; bj < 2; ++bj) {
                    const int c = col0 + bj * 128;
                    const u32x4 yv = *(const u32x4*)(ys + (size_t)r * 256 + c);
                    const f32x4 b0 = *(const f32x4*)(bias + c), b1 = *(const f32x4*)(bias + c + 4);
                    const f32x4 a0 = acc[ai][bj][m][0] + b0, a1 = acc[ai][bj][m][1] + b1;
                    float o[8];
                    o[0] = bflo(yv.x) * sigmoidf_(a0[0]); o[1] = bfhi(yv.x) * sigmoidf_(a0[1]); o[2] = bflo(yv.y) * sigmoidf_(a0[2]); o[3] = bfhi(yv.y) * sigmoidf_(a0[3]);
                    o[4] = bflo(yv.z) * sigmoidf_(a1[0]); o[5] = bfhi(yv.z) * sigmoidf_(a1[1]); o[6] = bflo(yv.w) * sigmoidf_(a1[2]); o[7] = bfhi(yv.w) * sigmoidf_(a1[3]);
                    u32x4 w; w.x = cvt_pk_bf16(o[0], o[1]); w.y = cvt_pk_bf16(o[2], o[3]); w.z = cvt_pk_bf16(o[4], o[5]); w.w = cvt_pk_bf16(o[6], o[7]);
                    *(u32x4*)(Y + (size_t)r * D + 512 + c) = w;
                }
            }
    }
};

template <bool F16>
__device__ __forceinline__ void transpose_convert(const float* __restrict__ src, int K, int N, int Npad, const float* __restrict__ gain, bf16_t* __restrict__ dst, int mapkind, int& base, int gw, int stride) {
    const int lane = threadIdx.x & 63, tk = K >> 7, ntasks = (Npad >> 6) * tk;
    int first = (gw - base) % stride; if (first < 0) first += stride;
    base += ntasks;
    for (int ti = first; ti < ntasks; ti += stride) {
        const int k0 = (ti % tk) << 7, n = ((ti / tk) << 6) + lane;
        const bool ok = n < N;
        const int row = mapkind == 0 ? n : ((n >> 7) * 256 + (n & 127) + (mapkind == 2 ? 128 : 0));
        const float* sp = src + (size_t)k0 * N + (ok ? n : 0);
        bf16_t* dp = dst + (size_t)row * K + k0;
#pragma unroll 2
        for (int kk = 0; kk < 128; kk += 16) {
            float v[16];
#pragma unroll
            for (int i = 0; i < 16; ++i) v[i] = __builtin_nontemporal_load(sp + (size_t)(kk + i) * N);
            if (gain) {
#pragma unroll
                for (int i = 0; i < 16; i += 4) { const f32x4 gq = *(const f32x4*)(gain + k0 + kk + i); v[i] *= gq[0]; v[i + 1] *= gq[1]; v[i + 2] *= gq[2]; v[i + 3] *= gq[3]; }
            }
            if (!ok) {
#pragma unroll
                for (int i = 0; i < 16; ++i) v[i] = 0.f;
            }
            u32x4 w0, w1;
            if (F16) {
                w0.x = cvt_pk_f16(v[0], v[1]); w0.y = cvt_pk_f16(v[2], v[3]); w0.z = cvt_pk_f16(v[4], v[5]); w0.w = cvt_pk_f16(v[6], v[7]);
                w1.x = cvt_pk_f16(v[8], v[9]); w1.y = cvt_pk_f16(v[10], v[11]); w1.z = cvt_pk_f16(v[12], v[13]); w1.w = cvt_pk_f16(v[14], v[15]);
            } else {
                w0.x = cvt_pk_bf16(v[0], v[1]); w0.y = cvt_pk_bf16(v[2], v[3]); w0.z = cvt_pk_bf16(v[4], v[5]); w0.w = cvt_pk_bf16(v[6], v[7]);
                w1.x = cvt_pk_bf16(v[8], v[9]); w1.y = cvt_pk_bf16(v[10], v[11]); w1.z = cvt_pk_bf16(v[12], v[13]); w1.w = cvt_pk_bf16(v[14], v[15]);
            }
            *(u32x4*)(dp + kk) = w0; *(u32x4*)(dp + kk + 8) = w1;
        }
    }
}
__device__ __forceinline__ void prologue(KP p, LAS unsigned char* lds) {
    bf16_t* W = (bf16_t*)(p->ws + WS_W);
    const int gw = blockIdx.x * 8 + (threadIdx.x >> 6), stride = gridDim.x * 8;
    int base = 0;
    for (int L = 0; L < 2; ++L) {
        bf16_t* WL = W + (size_t)L * LW;
        const size_t offFF = (size_t)L * D * FF;
        transpose_convert<true>(p->in[I_F1G] + offFF, D, FF, FF, p->in[I_F1N] + L * D, WL + LW_GU1, 1, base, gw, stride);
        transpose_convert<true>(p->in[I_F1U] + offFF, D, FF, FF, p->in[I_F1N] + L * D, WL + LW_GU1, 2, base, gw, stride);
        transpose_convert<false>(p->in[I_F1D] + offFF, FF, D, D, nullptr, WL + LW_D1, 0, base, gw, stride);
        transpose_convert<true>(p->in[I_WIN] + (size_t)L * D * 2696, D, 2696, DINP, p->in[I_MN] + L * D, WL + LW_IN, 0, base, gw, stride);
        transpose_convert<false>(p->in[I_WOUT] + (size_t)L * D * D, D, D, D, nullptr, WL + LW_OUT, 0, base, gw, stride);
        transpose_convert<true>(p->in[I_F2G] + offFF, D, FF, FF, p->in[I_F2N] + L * D, WL + LW_GU2, 1, base, gw, stride);
        transpose_convert<true>(p->in[I_F2U] + offFF, D, FF, FF, p->in[I_F2N] + L * D, WL + LW_GU2, 2, base, gw, stride);
        transpose_convert<false>(p->in[I_F2D] + offFF, FF, D, D, nullptr, WL + LW_D2, 0, base, gw, stride);
        transpose_convert<false>(p->in[I_SGW] + (size_t)L * 65536, 256, 256, 256, nullptr, WL + LW_GLU, 0, base, gw, stride);
    }
    const int wid = threadIdx.x >> 6, lane = threadIdx.x & 63;
    const float* x = p->in[I_X]; bf16_t* xb = (bf16_t*)(p->ws + WS_XB); float* ssq = (float*)(p->ws + WS_SSQ);
    for (int r = blockIdx.x * 8 + wid; r < T; r += gridDim.x * 8) {
        float s = 0.f;
#pragma unroll
        for (int i = 0; i < 4; ++i) {
            const size_t off = (size_t)r * D + i * 256 + lane * 4;
            const f32x4 v = __builtin_nontemporal_load((const f32x4*)(x + off));
            u32x2 w; w.x = cvt_pk_f16(v[0], v[1]); w.y = cvt_pk_f16(v[2], v[3]); *(u32x2*)(xb + off) = w;
            s += (v[0] * v[0] + v[1] * v[1]) + (v[2] * v[2] + v[3] * v[3]);
        }
        s = wave_sum64(s);
        if (lane == 0) { ssq[r] = s; ssq[T + r] = 0.f; }
    }
}
__device__ __forceinline__ void final_norm(KP p) {
    const int wid = threadIdx.x >> 6, lane = threadIdx.x & 63;
    float* out = p->out; const bf16_t* xb = (const bf16_t*)(p->ws + WS_XB); const float* ssq = (const float*)(p->ws + WS_SSQ); const float* g = p->in[I_FN];
    for (int r = blockIdx.x * 8 + wid; r < T; r += gridDim.x * 8) {
        const float rs = row_rstd(ssq, r);
#pragma unroll
        for (int i = 0; i < 4; ++i) {
            const size_t off = (size_t)r * D + i * 256 + lane * 4;
            const u32x2 xw = *(const u32x2*)(xb + off); const f32x4 gv = *(const f32x4*)(g + i * 256 + lane * 4);
            f32x4 v = (f32x4){f16lo(xw.x), f16hi(xw.x), f16lo(xw.y), f16hi(xw.y)};
            v = v * rs * gv; __builtin_nontemporal_store(v, (f32x4*)(out + off));
        }
    }
}

__device__ __forceinline__ int sw_off(int row, int k) { return row * 256 + ((((k >> 3) ^ (row & 15)) << 4) | ((k & 7) << 1)); }
__device__ __forceinline__ bf16x8 sw_frag(const LAS unsigned char* base, int r0, int ks, int lane) {
    const int row = r0 + (lane & 15), kg = 4 * ks + (lane >> 4);
    return *(const LAS bf16x8*)(base + row * 256 + ((kg ^ (row & 15)) << 4));
}
__device__ __forceinline__ int sw_off2(int row, int k) { return row * 256 + ((((k >> 3) ^ ((row ^ (row >> 3)) & 15)) << 4) | ((k & 7) << 1)); }
__device__ __forceinline__ bf16x8 sw_frag2(const LAS unsigned char* base, int r0, int ks, int lane) {
    const int row = r0 + (lane & 15), kg = 4 * ks + (lane >> 4);
    return *(const LAS bf16x8*)(base + row * 256 + ((kg ^ ((row ^ (row >> 3)) & 15)) << 4));
}
#define MFMA16(a, b, c) __builtin_amdgcn_mfma_f32_16x16x32_bf16((a), (b), (c), 0, 0, 0)

__device__ __forceinline__ void rwkv_prep_phase(KP p, int L, LAS unsigned char* lds) {
    const int tid = threadIdx.x, wid = tid >> 6, lane = tid & 63, h = wid & 3, sub = wid >> 2;
    const bf16_t* U = (const bf16_t*)(p->ws + WS_ACT); float* PF = p->out; bf16_t* PH = (bf16_t*)(p->ws + WS_Y);
    LAS float* M = (LAS float*)lds + wid * 1024;
    const int pc = lane * 4;
    int ucol;
    if (pc < 64) ucol = UR0 + h * 64 + pc; else if (pc < 128) ucol = UR0 + 256 + h * 64 + (pc - 64); else if (pc < 192) ucol = UR0 + 512 + h * 64 + (pc - 128);
    else if (pc < 224) ucol = UR0 + 768 + (pc - 192); else ucol = UR0 + 800 + (pc - 224);
    const bool istanh = (pc >= 192 && pc < 224);
    float mu4[4]; f32x2 w2p[16], a2p[16];
#pragma unroll
    for (int i = 0; i < 4; ++i) mu4[i] = p->in[I_RMU][L * 896 + (ucol - UR0) + i];
    const int ch = h * 64 + lane;
#pragma unroll
    for (int j = 0; j < 16; ++j) { w2p[j] = (f32x2){p->in[I_RW2][(L * 32 + 2 * j) * 256 + ch], p->in[I_RW2][(L * 32 + 2 * j + 1) * 256 + ch]}; a2p[j] = (f32x2){p->in[I_RA2][(L * 32 + 2 * j) * 256 + ch], p->in[I_RA2][(L * 32 + 2 * j + 1) * 256 + ch]}; }
    const float w0c = p->in[I_RW0][L * 256 + ch], a0c = p->in[I_RA0][L * 256 + ch], kkc = p->in[I_RKK][L * 256 + ch], kac = p->in[I_RKA][L * 256 + ch];
    const int nrun = T / 4, rstride = gridDim.x * 2;
    int run = blockIdx.x * 2 + sub;
    u32x2 nv[5];
    if (run < nrun) {
        const int t0 = run * 4; const bf16_t* up = U + (size_t)t0 * DINP + ucol;
        if ((t0 & (SEQ - 1)) == 0) nv[0] = (u32x2){0u, 0u}; else nv[0] = *(const u32x2*)(up - DINP);
#pragma unroll
        for (int i = 0; i < 4; ++i) nv[1 + i] = *(const u32x2*)(up + (size_t)i * DINP);
    }
    for (; run < nrun; run += rstride) {
        u32x2 cv[5];
#pragma unroll
        for (int i = 0; i < 5; ++i) cv[i] = nv[i];
        const int t0 = run * 4, bb = t0 >> 11, ts = t0 & (SEQ - 1);
        if (run + rstride < nrun) {
            const int t1 = (run + rstride) * 4; const bf16_t* up = U + (size_t)t1 * DINP + ucol;
            if ((t1 & (SEQ - 1)) == 0) nv[0] = (u32x2){0u, 0u}; else nv[0] = *(const u32x2*)(up - DINP);
#pragma unroll
            for (int i = 0; i < 4; ++i) nv[1 + i] = *(const u32x2*)(up + (size_t)i * DINP);
        }
#pragma unroll
        for (int i = 0; i < 4; ++i) {
            const u32x2 pv = cv[i], cc = cv[i + 1];
            const float c0 = bflo(cc.x), c1 = bfhi(cc.x), c2 = bflo(cc.y), c3 = bfhi(cc.y);
            const float p0 = bflo(pv.x), p1 = bfhi(pv.x), p2 = bflo(pv.y), p3 = bfhi(pv.y);
            f32x4 m; m[0] = c0 + (p0 - c0) * mu4[0]; m[1] = c1 + (p1 - c1) * mu4[1]; m[2] = c2 + (p2 - c2) * mu4[2]; m[3] = c3 + (p3 - c3) * mu4[3];
            *(LAS f32x4*)(M + i * 256 + pc) = m;
        }
#pragma unroll
        for (int k2 = 0; k2 < 2; ++k2) { LAS float* pm_ = M + ((lane >> 5) + 2 * k2) * 256 + 192 + (lane & 31); *pm_ = tanhf_(*pm_); }
        const size_t drow = ((size_t)(bb * 4 + h) * SEQ + ts) * 192;
#pragma unroll 2
        for (int i = 0; i < 4; ++i) {
            const LAS float* Mi = M + i * 256;
            const float xr = Mi[lane], xk = Mi[64 + lane], xv = Mi[128 + lane];
            f32x2 wac2 = (f32x2){w0c, 0.f}, aac2 = (f32x2){a0c, 0.f};
#pragma unroll
            for (int j = 0; j < 32; j += 4) {
                const f32x4 wl = *(const LAS f32x4*)(Mi + 192 + j), al = *(const LAS f32x4*)(Mi + 224 + j);
                wac2 = (f32x2){wl[0], wl[1]} * w2p[j >> 1] + wac2; wac2 = (f32x2){wl[2], wl[3]} * w2p[(j >> 1) + 1] + wac2;
                aac2 = (f32x2){al[0], al[1]} * a2p[j >> 1] + aac2; aac2 = (f32x2){al[2], al[3]} * a2p[(j >> 1) + 1] + aac2;
            }
            const float wacc = wac2[0] + wac2[1], aacc = aac2[0] + aac2[1];
            const float dec = __expf(-0.60653065971f * sigmoidf_(wacc));
            const float a = sigmoidf_(aacc);
            const float kkr = xk * kkc; const float ss = wave_sum64_dpp(kkr * kkr);
            const float kk = kkr * rsqrtf(fmaxf(ss, 1e-24f));
            const float kp = xk * (1.0f + (a - 1.0f) * kac);
            float* df = PF + drow + (size_t)i * 192; bf16_t* dh = PH + drow + (size_t)i * 192;
            df[lane] = dec; df[64 + lane] = kk; df[128 + lane] = kk * a;
            dh[lane] = f2bf(xr); dh[64 + lane] = f2bf(kp); dh[128 + lane] = f2bf(xv);
        }
    }
}

__device__ __forceinline__ float dpp_f(float v, int ctrl_sel) {
    int x;
    if (ctrl_sel == 0) x = __builtin_amdgcn_update_dpp(0, __float_as_int(v), 0xB1, 0xF, 0xF, true);
    else if (ctrl_sel == 1) x = __builtin_amdgcn_update_dpp(0, __float_as_int(v), 0x4E, 0xF, 0xF, true);
    else if (ctrl_sel == 2) x = __builtin_amdgcn_update_dpp(0, __float_as_int(v), 0x124, 0xF, 0xF, true);
    else x = __builtin_amdgcn_update_dpp(0, __float_as_int(v), 0x128, 0xF, 0xF, true);
    return __int_as_float(x);
}
__device__ __forceinline__ float row16_reduce4(float p0, float p1, float p2, float p3, bool odd1, bool odd2) {
    const float ka = odd1 ? p1 : p0, sa_ = odd1 ? p0 : p1, kb = odd1 ? p3 : p2, sb_ = odd1 ? p2 : p3;
    const float a_ = ka + dpp_f(sa_, 0), b_ = kb + dpp_f(sb_, 0);
    const float kc = odd2 ? b_ : a_, sc_ = odd2 ? a_ : b_;
    float c_ = kc + dpp_f(sc_, 1);
    c_ += dpp_f(c_, 2); c_ += dpp_f(c_, 3);
    return c_;
}
__device__ __forceinline__ void rwkv_unit(KP p, int L, LAS unsigned char* lds, int unit) {
    const int tid = threadIdx.x, wid = tid >> 6, lane = tid & 63;
    const int b = unit >> 3, h = (unit >> 1) & 3, half = unit & 1;
    bf16_t* yr = (bf16_t*)(p->ws + WS_YR);
    const unsigned char* PF = (const unsigned char*)p->out + (size_t)(b * 4 + h) * SEQ * 768; const unsigned char* PH = p->ws + WS_Y + (size_t)(b * 4 + h) * SEQ * 384;
    const size_t tb = (size_t)b * SEQ;
    LAS float* CBUF = (LAS float*)lds;
    f32x2 Sa = (f32x2){0.f, 0.f}, Sb = Sa, Sc = Sa, Sd = Sa;
    const int row = half * 32 + (wid & 3) * 8 + (lane >> 4), q = lane & 15, lt = tid - 256;
    for (int ck = -1; ck < 64; ++ck) {
        if (wid >= 4) {
            const int cn = ck + 1;
            if (cn < 64) {
                const unsigned char* srcf = PF + (size_t)cn * 32 * 768; const unsigned char* srch = PH + (size_t)cn * 32 * 384;
                LAS float* CB = CBUF + (cn & 1) * (32 * 384);
                u32x4 v[9];
#pragma unroll
                for (int j = 0; j < 6; ++j) v[j] = *(const u32x4*)(srcf + (size_t)(lt + 256 * j) * 16);
#pragma unroll
                for (int j = 0; j < 3; ++j) v[6 + j] = *(const u32x4*)(srch + (size_t)(lt + 256 * j) * 16);
#pragma unroll
                for (int j = 0; j < 6; ++j) { const int i = lt + 256 * j, tt = i / 48, off = i - tt * 48; *(LAS u32x4*)(CB + tt * 384 + off * 4) = v[j]; }
#pragma unroll
                for (int j = 0; j < 3; ++j) {
                    const int i = lt + 256 * j, tt = i / 24, o2 = i - tt * 24; LAS float* d = CB + tt * 384 + (3 + (o2 >> 3)) * 64 + (o2 & 7) * 8;
                    *(LAS f32x4*)d = (f32x4){bflo(v[6 + j].x), bfhi(v[6 + j].x), bflo(v[6 + j].y), bfhi(v[6 + j].y)};
                    *(LAS f32x4*)(d + 4) = (f32x4){bflo(v[6 + j].z), bfhi(v[6 + j].z), bflo(v[6 + j].w), bfhi(v[6 + j].w)};
                }
            }
        } else if (ck >= 0) {
            const LAS float* ct = CBUF + (ck & 1) * (32 * 384) + 4 * q;
            const LAS float* cvp = CBUF + (ck & 1) * (32 * 384) + 320 + row;
            bf16_t* yo = yr + (tb + (size_t)ck * 32) * 256 + h * 64 + row;
            f32x4 w4 = *(const LAS f32x4*)(ct), kk4 = *(const LAS f32x4*)(ct + 64), ka4 = *(const LAS f32x4*)(ct + 128), r4 = *(const LAS f32x4*)(ct + 192), k4 = *(const LAS f32x4*)(ct + 256);
            float vA = cvp[0], vB = cvp[4];
            float ykA = 0.f, ykB = 0.f; float ypA[4] = {0.f, 0.f, 0.f, 0.f}, ypB[4] = {0.f, 0.f, 0.f, 0.f};
            const bool odd1 = (q & 1) != 0, odd2 = (q & 2) != 0;
#pragma unroll
            for (int tt = 0; tt < 32; ++tt) {
                const int tn = (tt + 1 < 32) ? tt + 1 : tt;
                const f32x4 nw4 = *(const LAS f32x4*)(ct + tn * 384), nkk4 = *(const LAS f32x4*)(ct + tn * 384 + 64), nka4 = *(const LAS f32x4*)(ct + tn * 384 + 128);
                const f32x4 nr4 = *(const LAS f32x4*)(ct + tn * 384 + 192), nk4 = *(const LAS f32x4*)(ct + tn * 384 + 256); const float nvA = cvp[tn * 384], nvB = cvp[tn * 384 + 4];
                const f32x2 kkA = (f32x2){kk4[0], kk4[1]}, kkB = (f32x2){kk4[2], kk4[3]}, kaA = (f32x2){ka4[0], ka4[1]}, kaB = (f32x2){ka4[2], ka4[3]};
                const f32x2 kA = (f32x2){k4[0], k4[1]}, kB = (f32x2){k4[2], k4[3]}, wA = (f32x2){w4[0], w4[1]}, wB = (f32x2){w4[2], w4[3]}, rA = (f32x2){r4[0], r4[1]}, rB = (f32x2){r4[2], r4[3]};
                f32x2 t1 = Sa * kkA; t1 = Sb * kkB + t1;
                f32x2 t2 = Sc * kkA; t2 = Sd * kkB + t2;
                const float sa1 = -dpp_row_sum16(t1[0] + t1[1]);
                const float sa2 = -dpp_row_sum16(t2[0] + t2[1]);
                const f32x2 s1 = (f32x2){sa1, sa1}, v1 = (f32x2){vA, vA}, s2 = (f32x2){sa2, sa2}, v2 = (f32x2){vB, vB};
                Sa = Sa * wA + (s1 * kaA + v1 * kA); Sb = Sb * wB + (s1 * kaB + v1 * kB);
                Sc = Sc * wA + (s2 * kaA + v2 * kA); Sd = Sd * wB + (s2 * kaB + v2 * kB);
                f32x2 y1 = Sa * rA; y1 = Sb * rB + y1;
                f32x2 y2 = Sc * rA; y2 = Sd * rB + y2;
                ypA[tt & 3] = y1[0] + y1[1]; ypB[tt & 3] = y2[0] + y2[1];
                if ((tt & 3) == 3) {
                    const float yA = row16_reduce4(ypA[0], ypA[1], ypA[2], ypA[3], odd1, odd2);
                    const float yB = row16_reduce4(ypB[0], ypB[1], ypB[2], ypB[3], odd1, odd2);
                    const bool mine = (q >> 2) == ((tt >> 2) & 3);
                    ykA = mine ? yA : ykA; ykB = mine ? yB : ykB;
                }
                if ((tt & 15) == 15) { yo[(size_t)((tt & 16) + q) * 256] = f2bf(ykA); yo[(size_t)((tt & 16) + q) * 256 + 4] = f2bf(ykB); }
                w4 = nw4; kk4 = nkk4; ka4 = nka4; r4 = nr4; k4 = nk4; vA = nvA; vB = nvB;
            }
        }
        __syncthreads();
    }
}

struct SsdLds {
    LAS unsigned char *Cs, *Bs, *BT, *XT, *XdT, *StB; LAS float *Acs, *dts;
};
__device__ __forceinline__ SsdLds ssd_lds(LAS unsigned char* lds) {
    SsdLds m; m.Cs = lds; m.Bs = lds + 32768; m.BT = lds + 65536; m.XT = lds + 98304; m.XdT = lds + 114688; m.StB = lds + 131072;
    m.Acs = (LAS float*)(lds + 147456); m.dts = m.Acs + 128; return m;
}
struct SsdConst { float cw[8][4]; float cbias[8]; float Ah, dtbias, Dh; int ch0; };
__device__ __forceinline__ void conv8_silu(const u32x4& h0, const u32x4& h1, const u32x4& h2, const u32x4& h3, const float (&cw)[8][4], const float (&cbias)[8], float (&o)[8]) {
#pragma unroll
    for (int e = 0; e < 8; ++e) {
        const unsigned w0 = e < 2 ? h0.x : e < 4 ? h0.y : e < 6 ? h0.z : h0.w, w1 = e < 2 ? h1.x : e < 4 ? h1.y : e < 6 ? h1.z : h1.w;
        const unsigned w2 = e < 2 ? h2.x : e < 4 ? h2.y : e < 6 ? h2.z : h2.w, w3 = e < 2 ? h3.x : e < 4 ? h3.y : e < 6 ? h3.z : h3.w;
        const float v0 = (e & 1) ? bfhi(w0) : bflo(w0), v1 = (e & 1) ? bfhi(w1) : bflo(w1), v2 = (e & 1) ? bfhi(w2) : bflo(w2), v3 = (e & 1) ? bfhi(w3) : bflo(w3);
        const float sacc = cbias[e] + cw[e][0] * v0 + cw[e][1] * v1 + cw[e][2] * v2 + cw[e][3] * v3;
        o[e] = siluf_(sacc);
    }
}
__device__ __forceinline__ void ssd_bc_prepass(KP p, int L) {
    const int tid = threadIdx.x, cg = tid & 63, run = tid >> 6;
    const bf16_t* U = (const bf16_t*)(p->ws + WS_ACT); bf16_t* BCc = (bf16_t*)(p->ws + WS_BCC);
    float cw[8][4], cbias[8];
#pragma unroll
    for (int i = 0; i < 8; ++i) { const f32x4 w = *(const f32x4*)(p->in[I_MCW] + ((size_t)L * 1024 + 512 + cg * 8 + i) * 4); cw[i][0] = w[0]; cw[i][1] = w[1]; cw[i][2] = w[2]; cw[i][3] = w[3]; cbias[i] = p->in[I_MCB][L * 1024 + 512 + cg * 8 + i]; }
    for (int tile = blockIdx.x; tile < T / 128; tile += gridDim.x) {
        const int ta = tile * 128 + run * 16;
        const bf16_t* up = U + (size_t)ta * DINP + XBC0 + 512 + cg * 8;
        u32x4 hv[19];
#pragma unroll
        for (int i = 0; i < 3; ++i) { if ((ta & (SEQ - 1)) != 0) hv[i] = *(const u32x4*)(up - (3 - i) * DINP); else hv[i] = (u32x4){0u, 0u, 0u, 0u}; }
#pragma unroll
        for (int i = 0; i < 16; ++i) hv[3 + i] = *(const u32x4*)(up + (size_t)i * DINP);
#pragma unroll
        for (int i = 0; i < 16; ++i) {
            float o[8]; conv8_silu(hv[i], hv[i + 1], hv[i + 2], hv[i + 3], cw, cbias, o);
            u32x4 w; w.x = cvt_pk_bf16(o[0], o[1]); w.y = cvt_pk_bf16(o[2], o[3]); w.z = cvt_pk_bf16(o[4], o[5]); w.w = cvt_pk_bf16(o[6], o[7]);
            *(u32x4*)(BCc + (size_t)(ta + i) * 512 + cg * 8) = w;
        }
    }
}
__device__ __forceinline__ void ssd_stage(KP p, const SsdLds& m, const SsdConst& k, int b, int c, int hd, int tid) {
    const bf16_t* U = (const bf16_t*)(p->ws + WS_ACT); const float* dtb = (const float*)(p->ws + WS_DT); const bf16_t* BCc = (const bf16_t*)(p->ws + WS_BCC);
    const int lane = tid & 63, g = hd >> 2;
    const size_t t0 = (size_t)b * SEQ + c * 128;
    const int cgx = tid & 7, ls = (tid >> 3) * 2;
    u32x4 hv[5], bc[8];
    {
        const bf16_t* up = U + (t0 + ls) * DINP + XBC0 + k.ch0;
        const int lbase = c * 128 + ls;
#pragma unroll
        for (int i = 0; i < 3; ++i) { if (lbase - 3 + i >= 0) hv[i] = *(const u32x4*)(up - (3 - i) * DINP); else hv[i] = (u32x4){0u, 0u, 0u, 0u}; }
        hv[3] = *(const u32x4*)up; hv[4] = *(const u32x4*)(up + DINP);
#pragma unroll
        for (int j = 0; j < 8; ++j) { const int i = tid + 512 * j, l = i >> 5, cgb = i & 31; bc[j] = *(const u32x4*)(BCc + (t0 + l) * 512 + (cgb < 16 ? g * 128 + cgb * 8 : 256 + g * 128 + (cgb - 16) * 8)); }
    }
    if (tid >= 480) {
        const int j = lane - 32, l0 = 4 * j;
        float d[4], ac[4];
#pragma unroll
        for (int i = 0; i < 4; ++i) d[i] = softplusf_(dtb[(t0 + l0 + i) * 8 + hd] + k.dtbias);
        ac[0] = d[0] * k.Ah; ac[1] = ac[0] + d[1] * k.Ah; ac[2] = ac[1] + d[2] * k.Ah; ac[3] = ac[2] + d[3] * k.Ah;
        float inc = ac[3];
#pragma unroll
        for (int o = 1; o < 32; o <<= 1) { const float t = __shfl_up(inc, o); if (j >= o) inc += t; }
        const float ex = inc - ac[3];
        *(LAS f32x4*)(m.Acs + l0) = (f32x4){ex + ac[0], ex + ac[1], ex + ac[2], ex + ac[3]};
        *(LAS f32x4*)(m.dts + l0) = (f32x4){d[0], d[1], d[2], d[3]};
    }
#pragma unroll
    for (int i = 0; i < 2; ++i) {
        float o[8]; conv8_silu(hv[i], hv[i + 1], hv[i + 2], hv[i + 3], k.cw, k.cbias, o);
#pragma unroll
        for (int e = 0; e < 8; ++e) *(LAS bf16_t*)(m.XT + sw_off2(cgx * 8 + e, ls + i)) = f2bf(o[e]);
    }
#pragma unroll
    for (int j = 0; j < 8; ++j) {
        const int i = tid + 512 * j, l = i >> 5, cgb = i & 31;
        if (cgb < 16) {
            const int n0 = cgb * 8; const u32x4 w = bc[j];
            *(LAS u32x4*)(m.Bs + sw_off(l, n0)) = w;
            *(LAS bf16_t*)(m.BT + sw_off2(n0 + 0, l)) = (bf16_t)(w.x & 0xffffu); *(LAS bf16_t*)(m.BT + sw_off2(n0 + 1, l)) = (bf16_t)(w.x >> 16);
            *(LAS bf16_t*)(m.BT + sw_off2(n0 + 2, l)) = (bf16_t)(w.y & 0xffffu); *(LAS bf16_t*)(m.BT + sw_off2(n0 + 3, l)) = (bf16_t)(w.y >> 16);
            *(LAS bf16_t*)(m.BT + sw_off2(n0 + 4, l)) = (bf16_t)(w.z & 0xffffu); *(LAS bf16_t*)(m.BT + sw_off2(n0 + 5, l)) = (bf16_t)(w.z >> 16);
            *(LAS bf16_t*)(m.BT + sw_off2(n0 + 6, l)) = (bf16_t)(w.w & 0xffffu); *(LAS bf16_t*)(m.BT + sw_off2(n0 + 7, l)) = (bf16_t)(w.w >> 16);
        } else {
            *(LAS u32x4*)(m.Cs + sw_off(l, (cgb - 16) * 8)) = bc[j];
        }
    }
    __syncthreads();
    {
        const float alast = m.Acs[127];
#pragma unroll
        for (int it = 0; it < 2; ++it) {
            const int i = tid + 512 * it, pp = i >> 4, l0 = (i & 15) * 8;
            const u32x4 xv = *(const LAS u32x4*)(m.XT + sw_off2(pp, l0));
            const f32x4 a0 = *(const LAS f32x4*)(m.Acs + l0), a1 = *(const LAS f32x4*)(m.Acs + l0 + 4), d0 = *(const LAS f32x4*)(m.dts + l0), d1 = *(const LAS f32x4*)(m.dts + l0 + 4);
            u32x4 w;
            w.x = cvt_pk_bf16(bflo(xv.x) * d0[0] * __expf(alast - a0[0]), bfhi(xv.x) * d0[1] * __expf(alast - a0[1]));
            w.y = cvt_pk_bf16(bflo(xv.y) * d0[2] * __expf(alast - a0[2]), bfhi(xv.y) * d0[3] * __expf(alast - a0[3]));
            w.z = cvt_pk_bf16(bflo(xv.z) * d1[0] * __expf(alast - a1[0]), bfhi(xv.z) * d1[1] * __expf(alast - a1[1]));
            w.w = cvt_pk_bf16(bflo(xv.w) * d1[2] * __expf(alast - a1[2]), bfhi(xv.w) * d1[3] * __expf(alast - a1[3]));
            *(LAS u32x4*)(m.XdT + sw_off(pp, l0)) = w;
        }
    }
    __syncthreads();
}
__device__ __forceinline__ void ssd_load_const(KP p, int L, int hd, int tid, SsdConst& k) {
    k.ch0 = hd * 64 + (tid & 7) * 8;
#pragma unroll
    for (int i = 0; i < 8; ++i) { const f32x4 w = *(const f32x4*)(p->in[I_MCW] + ((size_t)L * 1024 + k.ch0 + i) * 4); k.cw[i][0] = w[0]; k.cw[i][1] = w[1]; k.cw[i][2] = w[2]; k.cw[i][3] = w[3]; k.cbias[i] = p->in[I_MCB][L * 1024 + k.ch0 + i]; }
    k.Ah = -__expf(p->in[I_MALOG][L * 8 + hd]); k.dtbias = p->in[I_MDTB][L * 8 + hd]; k.Dh = p->in[I_MD][L * 8 + hd];
}
__device__ __forceinline__ void ssd_passA(KP p, int L, LAS unsigned char* lds, int unit) {
    const int b = unit >> 4, hd = (unit >> 1) & 7, half = unit & 1;
    const SsdLds m = ssd_lds(lds);
    SsdConst k; ssd_load_const(p, L, hd, threadIdx.x, k);
    bf16_t* SL = (bf16_t*)(p->ws + WS_SL); float* DEC = (float*)(p->ws + WS_DEC);
    const int tid0 = threadIdx.x;
    for (int c = half * 4; c < half * 4 + 4; ++c) {
        int tidv = tid0; asm volatile("" : "+v"(tidv));
        const int tid = tidv, lane = tidv & 63, wid = tidv >> 6;
        ssd_stage(p, m, k, b, c, hd, tid);
        f32x4 st[4];
#pragma unroll
        for (int i = 0; i < 4; ++i) st[i] = (f32x4){0.f, 0.f, 0.f, 0.f};
#pragma unroll 1
        for (int ks = 0; ks < 4; ++ks) {
            const bf16x8 bb = sw_frag2(m.BT, 16 * wid, ks, lane);
#pragma unroll
            for (int pt = 0; pt < 4; ++pt) { const bf16x8 a = sw_frag(m.XdT, 16 * pt, ks, lane); st[pt] = MFMA16(bb, a, st[pt]); }
        }
        const int ua = (b * 8 + c) * 8 + hd;
#pragma unroll
        for (int pt = 0; pt < 4; ++pt) { u32x2 w; w.x = cvt_pk_bf16(st[pt][0], st[pt][1]); w.y = cvt_pk_bf16(st[pt][2], st[pt][3]); *(u32x2*)(SL + ((size_t)((ua * 8 + wid) * 4 + pt) * 64 + lane) * 4) = w; }
        if (tid == 0) DEC[ua] = __expf(m.Acs[127]);
        __syncthreads();
    }
}
__device__ __forceinline__ void ssd_passB(KP p, int L, LAS unsigned char* lds, int unit, bool whole) {
    const int b = unit >> 4, hd = (unit >> 1) & 7, half = whole ? 0 : (unit & 1);
    const int c_begin = half * 8, c_end = whole ? 16 : half * 8 + 8;
    const SsdLds m = ssd_lds(lds);
    SsdConst k; ssd_load_const(p, L, hd, threadIdx.x, k);
    bf16_t* ym = (bf16_t*)(p->ws + WS_YM);
    const bf16_t* SL = (const bf16_t*)(p->ws + WS_SL); const float* DEC = (const float*)(p->ws + WS_DEC);
    f32x4 st[4];
#pragma unroll
    for (int i = 0; i < 4; ++i) st[i] = (f32x4){0.f, 0.f, 0.f, 0.f};
    {
        const int lane = threadIdx.x & 63, wid = threadIdx.x >> 6, q4 = lane >> 4, c16 = lane & 15;
        if (half == 1) {
#pragma unroll
            for (int cp = 0; cp < 8; ++cp) {
                const int ua = (b * 8 + cp) * 8 + hd; const float dc = DEC[ua];
#pragma unroll
                for (int pt = 0; pt < 4; ++pt) {
                    const u32x2 w = *(const u32x2*)(SL + ((size_t)((ua * 8 + wid) * 4 + pt) * 64 + lane) * 4);
                    st[pt][0] = st[pt][0] * dc + bflo(w.x); st[pt][1] = st[pt][1] * dc + bfhi(w.x); st[pt][2] = st[pt][2] * dc + bflo(w.y); st[pt][3] = st[pt][3] * dc + bfhi(w.y);
                }
            }
        }
#pragma unroll
        for (int pt = 0; pt < 4; ++pt)
            { u32x2 w2; w2.x = cvt_pk_bf16(st[pt][0], st[pt][1]); w2.y = cvt_pk_bf16(st[pt][2], st[pt][3]); *(LAS u32x2*)(m.StB + sw_off(16 * pt + c16, 16 * wid + 4 * q4)) = w2; }
    }
    __syncthreads();
    const int tid0 = threadIdx.x;
    for (int c = c_begin; c < c_end; ++c) {
        int tidv = tid0; asm volatile("" : "+v"(tidv));
        const int tid = tidv, lane = tidv & 63, wid = tidv >> 6, q4 = lane >> 4, c16 = lane & 15;
        const size_t t0 = (size_t)b * SEQ + c * 128;
        ssd_stage(p, m, k, b, c, hd, tid);
        f32x4 yo[4], cb[8];
#pragma unroll
        for (int i = 0; i < 4; ++i) yo[i] = (f32x4){0.f, 0.f, 0.f, 0.f};
#pragma unroll
        for (int i = 0; i < 8; ++i) cb[i] = (f32x4){0.f, 0.f, 0.f, 0.f};
#pragma unroll 1
        for (int ks = 0; ks < 4; ++ks) {
            const bf16x8 a = sw_frag(m.Cs, 16 * wid, ks, lane);
#pragma unroll
            for (int pt = 0; pt < 4; ++pt) { const bf16x8 bb = sw_frag(m.StB, 16 * pt, ks, lane); yo[pt] = MFMA16(a, bb, yo[pt]); }
#pragma unroll
            for (int s8 = 0; s8 < 8; ++s8) { const bf16x8 bb = sw_frag(m.Bs, 16 * s8, ks, lane); cb[s8] = MFMA16(bb, a, cb[s8]); }
        }
        __syncthreads();
        {
            const int l = 16 * wid + c16; const float al = m.Acs[l];
#pragma unroll
            for (int s8 = 0; s8 < 8; ++s8) {
                const int s0 = 16 * s8 + 4 * q4;
                const f32x4 as4 = *(const LAS f32x4*)(m.Acs + s0), ds4 = *(const LAS f32x4*)(m.dts + s0);
                float gv[4];
#pragma unroll
                for (int j = 0; j < 4; ++j) gv[j] = (s0 + j <= l) ? cb[s8][j] * __expf(al - as4[j]) * ds4[j] : 0.f;
                u32x2 w2; w2.x = cvt_pk_bf16(gv[0], gv[1]); w2.y = cvt_pk_bf16(gv[2], gv[3]);
                *(LAS u32x2*)(m.Bs + sw_off(l, s0)) = w2;
            }
        }
        __syncthreads();
        {
            f32x4 yd[4];
#pragma unroll
            for (int i = 0; i < 4; ++i) yd[i] = (f32x4){0.f, 0.f, 0.f, 0.f};
#pragma unroll 1
            for (int ks = 0; ks < 4; ++ks) {
                const bf16x8 a = sw_frag(m.Bs, 16 * wid, ks, lane);
#pragma unroll
                for (int pt = 0; pt < 4; ++pt) { const bf16x8 bb = sw_frag2(m.XT, 16 * pt, ks, lane); yd[pt] = MFMA16(a, bb, yd[pt]); }
            }
#pragma unroll
            for (int j = 0; j < 4; ++j) {
                const int l = 16 * wid + 4 * q4 + j; const float ea = __expf(m.Acs[l]);
#pragma unroll
                for (int pt = 0; pt < 4; ++pt) {
                    const int pp = 16 * pt + c16;
                    const float xs = bf2f(*(const LAS bf16_t*)(m.XT + sw_off2(pp, l)));
                    ym[(t0 + l) * 512 + hd * 64 + pp] = f2bf(yd[pt][j] + ea * yo[pt][j] + k.Dh * xs);
                }
            }
            const float el = __expf(m.Acs[127]);
#pragma unroll
            for (int pt = 0; pt < 4; ++pt) st[pt] = st[pt] * el;
#pragma unroll 1
            for (int ks = 0; ks < 4; ++ks) {
                const bf16x8 bb = sw_frag2(m.BT, 16 * wid, ks, lane);
#pragma unroll
                for (int pt = 0; pt < 4; ++pt) { const bf16x8 a = sw_frag(m.XdT, 16 * pt, ks, lane); st[pt] = MFMA16(bb, a, st[pt]); }
            }
        }
        __syncthreads();
#pragma unroll
        for (int pt = 0; pt < 4; ++pt)
            { u32x2 w2; w2.x = cvt_pk_bf16(st[pt][0], st[pt][1]); w2.y = cvt_pk_bf16(st[pt][2], st[pt][3]); *(LAS u32x2*)(m.StB + sw_off(16 * pt + c16, 16 * wid + 4 * q4)) = w2; }
    }
    __syncthreads();
}

__device__ __forceinline__ void s5_unit(KP p, int L, LAS unsigned char* lds, int unit) {
    const int tid = threadIdx.x, wid = tid >> 6, lane = tid & 63, q4 = lane >> 4, c16 = lane & 15;
    const int b = unit >> 4, g = unit & 15;
    const bf16_t* U = (const bf16_t*)(p->ws + WS_ACT); bf16_t* ys = (bf16_t*)(p->ws + WS_YS);
    LAS unsigned char* Xs = lds;
    LAS float* Uf0 = (LAS float*)(lds + 65536);
    LAS float* E = (LAS float*)(lds + 65536 + 32768);
    const int pidx = lane, lg = wid;
    const float dt = __expf(p->in[I_SLDT][L * 16 + g]);
    const float Are = p->in[I_SARE][(L * 16 + g) * 64 + pidx], Aim = p->in[I_SAIM][(L * 16 + g) * 64 + pidx];
    const float mag = __expf(Are * dt); float sn, cs; sincosf(Aim * dt, &sn, &cs);
    const float abr = mag * cs, abi = mag * sn;
    const float den = Are * Are + Aim * Aim, nr = abr - 1.0f, ni = abi;
    const float cre = (nr * Are + ni * Aim) / den, cim = (ni * Are - nr * Aim) / den;
    f32x2 Bb[16];
#pragma unroll
    for (int h4 = 0; h4 < 16; h4 += 4) {
        const f32x4 br = *(const f32x4*)(p->in[I_SBRE] + ((size_t)(L * 16 + g) * 64 + pidx) * 16 + h4), bi = *(const f32x4*)(p->in[I_SBIM] + ((size_t)(L * 16 + g) * 64 + pidx) * 16 + h4);
#pragma unroll
        for (int e = 0; e < 4; ++e) { Bb[h4 + e] = (f32x2){cre * br[e] - cim * bi[e], cre * bi[e] + cim * br[e]}; }
    }
    float a32r = abr, a32i = abi;
#pragma unroll
    for (int i = 0; i < 5; ++i) { const float nr_ = a32r * a32r - a32i * a32i, ni_ = 2.0f * a32r * a32i; a32r = nr_; a32i = ni_; }
    bf16x8 cfrag[4];
#pragma unroll
    for (int ks = 0; ks < 4; ++ks) {
        const float* src = (ks < 2 ? p->in[I_SCRE] : p->in[I_SCIM]) + ((size_t)(L * 16 + g) * 16 + c16) * 64 + (32 * ks + 8 * q4) % 64;
        const f32x4 v0 = *(const f32x4*)src, v1 = *(const f32x4*)(src + 4); const float sg = ks < 2 ? 1.0f : -1.0f;
        union { u32x4 u; bf16x8 h; } cv;
        cv.u.x = cvt_pk_bf16(sg * v0[0], sg * v0[1]); cv.u.y = cvt_pk_bf16(sg * v0[2], sg * v0[3]); cv.u.z = cvt_pk_bf16(sg * v1[0], sg * v1[1]); cv.u.w = cvt_pk_bf16(sg * v1[2], sg * v1[3]);
        cfrag[ks] = cv.h;
    }
    const float dsk = p->in[I_SD][L * 256 + g * 16 + c16];
    float car = 0.f, cai = 0.f;
    const size_t tb = (size_t)b * SEQ;
    u32x4 unext;
    { const int l = tid >> 1, h8 = (tid & 1) * 8; unext = *(const u32x4*)(U + (tb + l) * DINP + US0 + g * 16 + h8); *(LAS f32x4*)(Uf0 + l * 16 + h8) = (f32x4){bflo(unext.x), bfhi(unext.x), bflo(unext.y), bfhi(unext.y)}; *(LAS f32x4*)(Uf0 + l * 16 + h8 + 4) = (f32x4){bflo(unext.z), bfhi(unext.z), bflo(unext.w), bfhi(unext.w)}; }
    __syncthreads();
    const int tid0 = tid;
    for (int c = 0; c < 8; ++c) {
        int tidv = tid0; asm volatile("" : "+v"(tidv));
        const int tid = tidv, lane = tidv & 63, wid = tidv >> 6, q4 = lane >> 4, c16 = lane & 15, pidx = lane, lg = wid;
        const size_t t0 = tb + c * 256;
        LAS float* Uf = Uf0 + (c & 1) * 4096;
        if (c + 1 < 8) { const int l = tid >> 1, h8 = (tid & 1) * 8; unext = *(const u32x4*)(U + (t0 + 256 + l) * DINP + US0 + g * 16 + h8); }
        float xr[32], xi[32]; float sr = 0.f, si = 0.f;
#pragma unroll
        for (int i = 0; i < 32; ++i) {
            const LAS float* ul = Uf + (lg * 32 + i) * 16;
            f32x2 bacc = (f32x2){0.f, 0.f}, bacc2 = (f32x2){0.f, 0.f};
#pragma unroll
            for (int h4 = 0; h4 < 16; h4 += 4) { const f32x4 uv = *(const LAS f32x4*)(ul + h4);
                bacc = (f32x2){uv[0], uv[0]} * Bb[h4] + bacc; bacc2 = (f32x2){uv[1], uv[1]} * Bb[h4 + 1] + bacc2;
                bacc = (f32x2){uv[2], uv[2]} * Bb[h4 + 2] + bacc; bacc2 = (f32x2){uv[3], uv[3]} * Bb[h4 + 3] + bacc2; }
            bacc = bacc + bacc2;
            const float nr2 = abr * sr - abi * si + bacc[0], ni2 = abr * si + abi * sr + bacc[1]; sr = nr2; si = ni2; xr[i] = sr; xi[i] = si;
        }
        E[(lg * 64 + pidx) * 2] = sr; E[(lg * 64 + pidx) * 2 + 1] = si;
        __syncthreads();
        float cr = car, ci = cai, cinr = 0.f, cini = 0.f;
#pragma unroll
        for (int j = 0; j < 8; ++j) {
            if (j == lg) { cinr = cr; cini = ci; }
            const float er = E[(j * 64 + pidx) * 2], ei = E[(j * 64 + pidx) * 2 + 1];
            const float nr2 = a32r * cr - a32i * ci + er, ni2 = a32r * ci + a32i * cr + ei; cr = nr2; ci = ni2;
        }
        car = cr; cai = ci;
        float cpr = cinr, cpi = cini;
#pragma unroll
        for (int i = 0; i < 32; ++i) {
            { const float nr_ = cpr * abr - cpi * abi, ni_ = cpr * abi + cpi * abr; cpr = nr_; cpi = ni_; }
            const float fr = xr[i] + cpr, fi = xi[i] + cpi;
            const int l = lg * 32 + i;
            *(LAS bf16_t*)(Xs + sw_off(l, pidx)) = f2bf(fr); *(LAS bf16_t*)(Xs + sw_off(l, 64 + pidx)) = f2bf(fi);
        }
        __syncthreads();
#pragma unroll
        for (int mt = 0; mt < 2; ++mt) {
            f32x4 acc = (f32x4){0.f, 0.f, 0.f, 0.f};
#pragma unroll
            for (int ks = 0; ks < 4; ++ks) { const bf16x8 a = sw_frag(Xs, 16 * (wid + 8 * mt), ks, lane); acc = MFMA16(a, cfrag[ks], acc); }
#pragma unroll
            for (int j = 0; j < 4; ++j) {
                const int l = 16 * (wid + 8 * mt) + 4 * q4 + j;
                const float y = acc[j] + dsk * Uf[l * 16 + c16];
                const float ge = 0.5f * y * (1.0f + tanhf_(0.7978845608f * (y + 0.044715f * y * y * y)));
                ys[(t0 + l) * 256 + g * 16 + c16] = f2bf(ge);
            }
        }
        if (c + 1 < 8) { const int l = tid >> 1, h8 = (tid & 1) * 8; LAS float* Un = Uf0 + ((c + 1) & 1) * 4096; *(LAS f32x4*)(Un + l * 16 + h8) = (f32x4){bflo(unext.x), bfhi(unext.x), bflo(unext.y), bfhi(unext.y)}; *(LAS f32x4*)(Un + l * 16 + h8 + 4) = (f32x4){bflo(unext.z), bfhi(unext.z), bflo(unext.w), bfhi(unext.w)}; }
        __syncthreads();
    }
}

__device__ __forceinline__ void post_tokens(KP p, int L, LAS unsigned char* lds) {
    const int tid = threadIdx.x, wid = tid >> 6, lane = tid & 63;
    LAS float* A2 = (LAS float*)lds;
    LAS float* G2 = (LAS float*)(lds + 32768);
    LAS float* SC = (LAS float*)(lds + 98304) + wid * 192;
    for (int i = tid; i < 32 * 256; i += 512) A2[i] = p->in[I_RA2][L * 8192 + i];
    for (int i = tid; i < 64 * 256; i += 512) G2[i] = p->in[I_RG2][L * 16384 + i];
    __syncthreads();
    const bf16_t* U = (const bf16_t*)(p->ws + WS_ACT); const bf16_t* ym = (const bf16_t*)(p->ws + WS_YM); const bf16_t* yr = (const bf16_t*)(p->ws + WS_YR);
    bf16_t* Y = (bf16_t*)(p->ws + WS_Y);
    const int c8 = lane * 8, c4 = lane * 4, hh = lane >> 4;
    float nw[8];
#pragma unroll
    for (int i = 0; i < 8; ++i) nw[i] = p->in[I_MNW][L * 512 + c8 + i];
    float mur[4], muk[4], muv[4], mux[4], a0v[4], kav[4], rkv[4], gnw[4], gnb[4];
#pragma unroll
    for (int i = 0; i < 4; ++i) {
        mur[i] = p->in[I_RMU][L * 896 + c4 + i]; muk[i] = p->in[I_RMU][L * 896 + 256 + c4 + i]; muv[i] = p->in[I_RMU][L * 896 + 512 + c4 + i];
        mux[i] = (lane < 24) ? p->in[I_RMU][L * 896 + 800 + c4 + i] : 0.f;
        a0v[i] = p->in[I_RA0][L * 256 + c4 + i]; kav[i] = p->in[I_RKA][L * 256 + c4 + i]; rkv[i] = p->in[I_RRK][L * 256 + c4 + i];
        gnw[i] = p->in[I_RGNW][L * 256 + c4 + i]; gnb[i] = p->in[I_RGNB][L * 256 + c4 + i];
    }
    struct PL { u32x4 yw, zw; u32x2 cr, ck, cv, cx, pr, pk, pv, px, yrw; };
    auto post_load = [&](int t) -> PL {
        PL q; const bf16_t* ut = U + (size_t)t * DINP; const bf16_t* ur = ut + UR0;
        q.yw = *(const u32x4*)(ym + (size_t)t * 512 + c8); q.zw = *(const u32x4*)(ut + Z0 + c8);
        q.cr = *(const u32x2*)(ur + c4); q.ck = *(const u32x2*)(ur + 256 + c4); q.cv = *(const u32x2*)(ur + 512 + c4); q.cx = (u32x2){0u, 0u};
        if (lane < 24) q.cx = *(const u32x2*)(ur + 800 + c4);
        q.pr = (u32x2){0u, 0u}; q.pk = q.pr; q.pv = q.pr; q.px = q.pr;
        if ((t & (SEQ - 1)) != 0) { q.pr = *(const u32x2*)(ur - DINP + c4); q.pk = *(const u32x2*)(ur - DINP + 256 + c4); q.pv = *(const u32x2*)(ur - DINP + 512 + c4); if (lane < 24) q.px = *(const u32x2*)(ur - DINP + 800 + c4); }
        q.yrw = *(const u32x2*)(yr + (size_t)t * 256 + c4);
        return q;
    };
    const int tstride = gridDim.x * 8;
    for (int t0 = blockIdx.x * 8 + wid; t0 < T; t0 += 2 * tstride) {
        const int t1 = t0 + tstride; const bool two = t1 < T;
        PL cu2[2]; cu2[0] = post_load(t0); cu2[1] = post_load(two ? t1 : t0);
        float xr[2][4], xk[2][4], xv[2][4];
#pragma unroll
        for (int u = 0; u < 2; ++u) {
            const PL& cu = cu2[u]; const int t = u ? t1 : t0;
            {
                const u32x4 yw = cu.yw;
                const f32x4 y0 = (f32x4){bflo(yw.x), bfhi(yw.x), bflo(yw.y), bfhi(yw.y)}, y1 = (f32x4){bflo(yw.z), bfhi(yw.z), bflo(yw.w), bfhi(yw.w)};
                const u32x4 zw = cu.zw;
                float v[8];
                v[0] = y0[0] * siluf_(bflo(zw.x)); v[1] = y0[1] * siluf_(bfhi(zw.x)); v[2] = y0[2] * siluf_(bflo(zw.y)); v[3] = y0[3] * siluf_(bfhi(zw.y));
                v[4] = y1[0] * siluf_(bflo(zw.z)); v[5] = y1[1] * siluf_(bfhi(zw.z)); v[6] = y1[2] * siluf_(bflo(zw.w)); v[7] = y1[3] * siluf_(bfhi(zw.w));
                float sq = 0.f;
#pragma unroll
                for (int i = 0; i < 8; ++i) sq += v[i] * v[i];
                sq = wave_sum64_dpp(sq);
                const float rs = rsqrtf(sq * (1.0f / 512.0f) + EPS);
                u32x4 w; w.x = cvt_pk_bf16(v[0] * rs * nw[0], v[1] * rs * nw[1]); w.y = cvt_pk_bf16(v[2] * rs * nw[2], v[3] * rs * nw[3]);
                w.z = cvt_pk_bf16(v[4] * rs * nw[4], v[5] * rs * nw[5]); w.w = cvt_pk_bf16(v[6] * rs * nw[6], v[7] * rs * nw[7]);
                if (u == 0 || two) *(u32x4*)(Y + (size_t)t * D + c8) = w;
            }
            {
                const u32x2 cr = cu.cr, ck = cu.ck, cv = cu.cv, cx = cu.cx, pr = cu.pr, pk = cu.pk, pv = cu.pv, px = cu.px;
                float xx[4];
                {
                    const float c_[4] = {bflo(cr.x), bfhi(cr.x), bflo(cr.y), bfhi(cr.y)}, p_[4] = {bflo(pr.x), bfhi(pr.x), bflo(pr.y), bfhi(pr.y)};
#pragma unroll
                    for (int i = 0; i < 4; ++i) xr[u][i] = c_[i] + (p_[i] - c_[i]) * mur[i];
                }
                {
                    const float c_[4] = {bflo(ck.x), bfhi(ck.x), bflo(ck.y), bfhi(ck.y)}, p_[4] = {bflo(pk.x), bfhi(pk.x), bflo(pk.y), bfhi(pk.y)};
#pragma unroll
                    for (int i = 0; i < 4; ++i) xk[u][i] = c_[i] + (p_[i] - c_[i]) * muk[i];
                }
                {
                    const float c_[4] = {bflo(cv.x), bfhi(cv.x), bflo(cv.y), bfhi(cv.y)}, p_[4] = {bflo(pv.x), bfhi(pv.x), bflo(pv.y), bfhi(pv.y)};
#pragma unroll
                    for (int i = 0; i < 4; ++i) xv[u][i] = c_[i] + (p_[i] - c_[i]) * muv[i];
                }
                {
                    const float c_[4] = {bflo(cx.x), bfhi(cx.x), bflo(cx.y), bfhi(cx.y)}, p_[4] = {bflo(px.x), bfhi(px.x), bflo(px.y), bfhi(px.y)};
#pragma unroll
                    for (int i = 0; i < 4; ++i) xx[i] = c_[i] + (p_[i] - c_[i]) * mux[i];
                }
                if (lane < 8) { *(LAS f32x4*)(SC + u * 96 + c4) = (f32x4){xx[0], xx[1], xx[2], xx[3]}; }
                else if (lane < 24) { *(LAS f32x4*)(SC + u * 96 + c4) = (f32x4){sigmoidf_(xx[0]), sigmoidf_(xx[1]), sigmoidf_(xx[2]), sigmoidf_(xx[3])}; }
            }
        }
        f32x4 aa0 = (f32x4){a0v[0], a0v[1], a0v[2], a0v[3]}, aa1 = aa0, gg0 = (f32x4){0.f, 0.f, 0.f, 0.f}, gg1 = gg0;
#pragma unroll 8
        for (int j = 0; j < 32; ++j) { const float s0 = SC[j], s1 = SC[96 + j]; const f32x4 w = *(const LAS f32x4*)(A2 + j * 256 + c4); aa0 += w * s0; aa1 += w * s1; }
#pragma unroll 8
        for (int j = 0; j < 64; ++j) { const float s0 = SC[32 + j], s1 = SC[128 + j]; const f32x4 w = *(const LAS f32x4*)(G2 + j * 256 + c4); gg0 += w * s0; gg1 += w * s1; }
#pragma unroll
        for (int u = 0; u < 2; ++u) {
            const f32x4 aa = u ? aa1 : aa0, gg = u ? gg1 : gg0; const int t = u ? t1 : t0;
            float bon = 0.f;
#pragma unroll
            for (int i = 0; i < 4; ++i) { const float a = sigmoidf_(aa[i]); const float kp = xk[u][i] * (1.0f + (a - 1.0f) * kav[i]); bon += xr[u][i] * kp * rkv[i]; }
            bon = dpp_row_sum16(bon);
            const u32x2 yrw = cu2[u].yrw; const f32x4 yv = (f32x4){bflo(yrw.x), bfhi(yrw.x), bflo(yrw.y), bfhi(yrw.y)};
            float mean = (yv[0] + yv[1]) + (yv[2] + yv[3]); mean = dpp_row_sum16(mean) * (1.0f / 64.0f);
            const float d0 = yv[0] - mean, d1 = yv[1] - mean, d2 = yv[2] - mean, d3 = yv[3] - mean;
            float var = (d0 * d0 + d1 * d1) + (d2 * d2 + d3 * d3); var = dpp_row_sum16(var) * (1.0f / 64.0f);
            const float rstd = rsqrtf(var + 64e-5f);
            const float o0 = (d0 * rstd * gnw[0] + gnb[0] + bon * xv[u][0]) * gg[0], o1 = (d1 * rstd * gnw[1] + gnb[1] + bon * xv[u][1]) * gg[1];
            const float o2 = (d2 * rstd * gnw[2] + gnb[2] + bon * xv[u][2]) * gg[2], o3 = (d3 * rstd * gnw[3] + gnb[3] + bon * xv[u][3]) * gg[3];
            u32x2 w; w.x = cvt_pk_bf16(o0, o1); w.y = cvt_pk_bf16(o2, o3);
            if (u == 0 || two) *(u32x2*)(Y + (size_t)t * D + 768 + c4) = w;
        }
    }
}

#define XB_TMO      128
#define XB_XCNT(j)  (256  + 64 * (j))
#define XB_XSUB(j)  (1280 + 64 * (j))
#define XB_XGEN(j)  (2304 + 64 * (j))
#define XB_TOP      3328
#define XB_TOPGEN   3392
#define XCD_BAR_WORDS 3456
#define XB_SPIN_CAP (1u << 22)
__device__ __forceinline__ unsigned xb_ld(unsigned* p)              { return __hip_atomic_load(p, __ATOMIC_RELAXED, __HIP_MEMORY_SCOPE_AGENT); }
__device__ __forceinline__ unsigned xb_add(unsigned* p, unsigned v) { return __hip_atomic_fetch_add(p, v, __ATOMIC_RELAXED, __HIP_MEMORY_SCOPE_AGENT); }
__device__ __forceinline__ unsigned xb_xcc_id() { return (unsigned)__builtin_amdgcn_s_getreg((3 << 11) | 20) & 0xFu; }
#define XB_SPIN(cond, bar) do { unsigned _sp = 0; while (cond) { __builtin_amdgcn_s_sleep(1); \
    if ((++_sp & 255u) == 0u) { if (xb_ld(&(bar)[XB_TMO])) break; if (_sp > XB_SPIN_CAP) { atomicAdd(&(bar)[XB_TMO], 1u); break; } } } } while (0)
struct XcdBarrier { unsigned* bar; unsigned x; volatile LAS unsigned* st; };
__device__ __forceinline__ XcdBarrier xcd_barrier_post(unsigned* bar, volatile LAS unsigned* st) {
    XcdBarrier b; b.bar = bar; b.x = xb_xcc_id(); b.st = st;
    if (threadIdx.x == 0) (void)xb_add(&bar[XB_XCNT(b.x)], 1u);
    return b;
}
__device__ __forceinline__ void xcd_barrier_complete(unsigned* bar, unsigned x, unsigned& nloc, unsigned& nx) {
    const unsigned G = gridDim.x * gridDim.y * gridDim.z;
    unsigned sum, cnt, mine, sp = 0u;
    for (;;) {
        sum = 0u; cnt = 0u; mine = 0u;
#pragma unroll
        for (unsigned j = 0; j < 16; ++j) { const unsigned c = xb_ld(&bar[XB_XCNT(j)]); sum += c; cnt += (c > 0u) ? 1u : 0u; mine = (j == x) ? c : mine; }
        if (sum == G) break;
        __builtin_amdgcn_s_sleep(1);
        if ((++sp & 255u) == 0u) { if (xb_ld(&bar[XB_TMO])) break; if (sp > XB_SPIN_CAP) { atomicAdd(&bar[XB_TMO], 1u); break; } }
    }
    nloc = mine > 0u ? mine : 1u; nx = cnt > 0u ? cnt : 1u;
}
__device__ __forceinline__ void xcd_barrier(const XcdBarrier& b) {
    asm volatile("s_waitcnt vmcnt(0)" ::: "memory");
    __syncthreads();
    if (threadIdx.x == 0) {
        unsigned* bar = b.bar;
        __builtin_amdgcn_s_waitcnt(0);
        unsigned nloc = b.st[0], nx = b.st[1];
        if (nloc == 0u) { xcd_barrier_complete(bar, b.x, nloc, nx); b.st[0] = nloc; b.st[1] = nx; }
        const unsigned old = xb_add(&bar[XB_XSUB(b.x)], 1u);
        const unsigned gen = old / nloc;
        if (old + 1u == (gen + 1u) * nloc) {
            __builtin_amdgcn_fence(__ATOMIC_RELEASE, "agent");
            asm volatile("s_waitcnt vmcnt(0)" ::: "memory");
            const unsigned og = xb_add(&bar[XB_TOP], 1u);
            const unsigned tg = og / nx;
            if (og + 1u == (tg + 1u) * nx) xb_add(&bar[XB_TOPGEN], 1u);
            else XB_SPIN(xb_ld(&bar[XB_TOPGEN]) == tg, bar);
            __builtin_amdgcn_fence(__ATOMIC_ACQUIRE, "agent");
            xb_add(&bar[XB_XGEN(b.x)], 1u);
            asm volatile("s_waitcnt vmcnt(0)" ::: "memory");
        } else {
            XB_SPIN(xb_ld(&bar[XB_XGEN(b.x)]) == gen, bar);
            __builtin_amdgcn_fence(__ATOMIC_ACQUIRE, "agent");
            asm volatile("s_waitcnt vmcnt(0)" ::: "memory");
        }
    }
    __syncthreads();
}

constexpr int PH_PER_LAYER = 9, N_PHASES = 2 + 2 * PH_PER_LAYER;
#ifndef PROBE_ID
#define PROBE_ID 0
#endif
#define REPS(id) ((PROBE_ID == (id)) ? 2 : 1)
#define IN_PH(k) (p->ph_lo <= (k) && (k) < p->ph_hi)
#define SEAM(k) do { if (IN_PH(k) && IN_PH((k) + 1)) xcd_barrier(bar); } while (0)
template <int L>
__device__ __forceinline__ void layer_phases(LAS unsigned char* lds, const XcdBarrier& bar) {
    const int G = gridDim.x, blk = blockIdx.x;
    constexpr int P0 = 1 + PH_PER_LAYER * L;
    KP p = fresh_kp();
    bf16_t* W = (bf16_t*)(p->ws + WS_W);
    const bf16_t* WL = W + (size_t)L * LW;
    bf16_t* XB = (bf16_t*)(p->ws + WS_XB); bf16_t* Y = (bf16_t*)(p->ws + WS_Y); bf16_t* ACT = (bf16_t*)(p->ws + WS_ACT);
    float* DTB = (float*)(p->ws + WS_DT); float* SSQ = (float*)(p->ws + WS_SSQ); bf16_t* YS = (bf16_t*)(p->ws + WS_YS);
    float* const SQa = SSQ + (size_t)(L & 1) * T; float* const SQb = SSQ + (size_t)((L + 1) & 1) * T;
#define ZERO_ROWS(buf) do { for (int r_ = blk * 512 + (int)threadIdx.x; r_ < T; r_ += G * 512) (buf)[r_] = 0.f; } while (0)
    if (IN_PH(P0 + 0)) {
        pg8::StaticOrder S; pg8::Gemm g{XB, WL + LW_GU1, T, 5632, D}; S.init(T, 5632, G, blk);
        EpiSwiglu E{ACT, SQa}; for (int rep = 0; rep < REPS(2); ++rep) pg8::gemm_phase<true>(lds, g, S, E);
    }
    SEAM(P0 + 0);
    if (IN_PH(P0 + 1)) {
        pg8::StaticOrder S; pg8::Gemm g{ACT, WL + LW_D1, T, D, FF}; S.init(T, D, G, blk);
        ZERO_ROWS(SQa);
        EpiResid E{XB, SQb, 0.5f}; pg8::gemm_phase(lds, g, S, E);
    }
    SEAM(P0 + 1);
    if (IN_PH(P0 + 2)) {
        pg8::StaticOrder S; pg8::Gemm g{XB, WL + LW_IN, T, DINP, D}; S.init(T, DINP, G, blk);
        EpiU E{ACT, DTB, SQb}; for (int rep = 0; rep < REPS(4); ++rep) pg8::gemm_phase<true>(lds, g, S, E);
    }
    SEAM(P0 + 2);
    if (IN_PH(P0 + 3)) {
        rwkv_prep_phase(p, L, lds); __syncthreads();
        ssd_bc_prepass(p, L);
        if (PROBE_ID == 5) { rwkv_prep_phase(fresh_kp(), L, lds); __syncthreads(); }
        for (int rep = 0; rep < REPS(6); ++rep)
        if (G != 256) for (int u = blk; u < 256; u += G) ssd_passA(p, L, lds, u);
        for (int rep = 0; rep < REPS(7); ++rep)
        for (int u = blk; u < 256; u += G) s5_unit(p, L, lds, u);
    }
    SEAM(P0 + 3);
    if (IN_PH(P0 + 4)) {
        if (G == 256) {
            const int xcd = blk & 7, slot = (blk >> 3) & 15;
            if (blk < 128) rwkv_unit(p, L, lds, ((xcd * 8 + (slot >> 1)) << 1) | (slot & 1));
            if (blk >= 128) { const int gi = xcd * 4 + (slot >> 2), bb_ = gi >> 1, hd_ = (gi & 1) * 4 + (slot & 3); ssd_passB(p, L, lds, 2 * (bb_ * 8 + hd_), true); }
        } else {
            for (int u = blk; u < 128; u += G) rwkv_unit(p, L, lds, u);
            for (int u = blk; u < 256; u += G) ssd_passB(p, L, lds, u, false);
        }
    }
    SEAM(P0 + 4);
    if (IN_PH(P0 + 5)) {
        pg8::StaticOrder S; pg8::Gemm g{YS, WL + LW_GLU, T, 256, 256}; S.init(T, 256, G, blk);
        EpiGlu E{YS, p->in[I_SGB] + L * 256, Y};
        pg8::gemm_phase(lds, g, S, E); __syncthreads(); post_tokens(p, L, lds); __syncthreads();
        if (PROBE_ID == 10) { post_tokens(fresh_kp(), L, lds); __syncthreads(); }
    }
    SEAM(P0 + 5);
    if (IN_PH(P0 + 6)) {
        pg8::StaticOrder S; pg8::Gemm g{Y, WL + LW_OUT, T, D, D}; S.init(T, D, G, blk);
        ZERO_ROWS(SQb);
        EpiResid E{XB, SQa, 1.0f}; pg8::gemm_phase(lds, g, S, E);
    }
    SEAM(P0 + 6);
    if (IN_PH(P0 + 7)) {
        pg8::StaticOrder S; pg8::Gemm g{XB, WL + LW_GU2, T, 5632, D}; S.init(T, 5632, G, blk);
        EpiSwiglu E{ACT, SQa}; pg8::gemm_phase<true>(lds, g, S, E);
    }
    SEAM(P0 + 7);
    if (IN_PH(P0 + 8)) {
        pg8::StaticOrder S; pg8::Gemm g{ACT, WL + LW_D2, T, D, FF}; S.init(T, D, G, blk);
        ZERO_ROWS(SQa);
        EpiResid E{XB, SQb, 0.5f}; pg8::gemm_phase(lds, g, S, E);
    }
    SEAM(P0 + 8);
}
__global__ void __launch_bounds__(512, 2) fwd_megakernel(Params p_unused) {
    extern __shared__ __attribute__((aligned(16))) unsigned char lds_raw[];
    LAS unsigned char* lds = (LAS unsigned char*)lds_raw;
    cg::grid_group grid = cg::this_grid();
    KP p = fresh_kp();
    volatile LAS unsigned* bst = (volatile LAS unsigned*)(lds + LDS_BYTES - 64);
    if (threadIdx.x == 0) { bst[0] = 0u; bst[1] = 0u; }
    unsigned* barw = (unsigned*)(p->ws + WS_BAR);
    if (blockIdx.x == 0) for (int i = threadIdx.x; i < XCD_BAR_WORDS; i += 512) barw[i] = 0u;
    prologue(fresh_kp(), lds);
    grid.sync();
    const XcdBarrier bar = xcd_barrier_post(barw, bst);
    if (PROBE_ID == 11) { for (int i = 0; i < 20; ++i) xcd_barrier(bar); }
    layer_phases<0>(lds, bar);
    layer_phases<1>(lds, bar);
    final_norm(fresh_kp());
}

extern "C" void kernel_launch(void* const* d_in, const int* in_sizes, int n_in, void* d_out, int out_size, void* d_ws, size_t ws_size, hipStream_t stream) {
    static int grid_blocks = 0;
    if (grid_blocks == 0) {
        if (n_in != N_IN || out_size != T * D || ws_size < WS_END) { fprintf(stderr, "kernel_launch: unexpected shapes (n_in %d, out %d, ws %zu, need %zu)\n", n_in, out_size, ws_size, (size_t)WS_END); grid_blocks = -1; return; }
        int dev = 0, cus = 0, per_cu = 0;
        hipGetDevice(&dev);
        hipDeviceGetAttribute(&cus, hipDeviceAttributeMultiprocessorCount, dev);
        hipFuncSetAttribute((const void*)fwd_megakernel, hipFuncAttributeMaxDynamicSharedMemorySize, LDS_BYTES);
        hipOccupancyMaxActiveBlocksPerMultiprocessor(&per_cu, (const void*)fwd_megakernel, 512, LDS_BYTES);
        if (per_cu < 1) { fprintf(stderr, "kernel_launch: occupancy query says %d blocks per CU\n", per_cu); per_cu = 1; }
        grid_blocks = cus * per_cu;
        (void)hipGetLastError();
    }
    if (grid_blocks < 0) return;
    Params p{};
    for (int i = 0; i < N_IN; ++i) p.in[i] = (const float*)d_in[i];
    p.out = (float*)d_out; p.ws = (unsigned char*)d_ws; p.ph_lo = 0; p.ph_hi = N_PHASES;
    void* args[] = {&p};
    hipError_t e = hipLaunchCooperativeKernel((const void*)fwd_megakernel, dim3(grid_blocks), dim3(512), args, LDS_BYTES, stream);
    if (e != hipSuccess) fprintf(stderr, "cooperative launch failed: %s (grid %d)\n", hipGetErrorString(e), grid_blocks);
}
```
